# Optimizing an MI355X kernel written in HIP

```python
import jax, jax.numpy as jnp
from jax import lax
import numpy as np

D_MODEL = 1024
BATCH = 8
SEQ = 4096
DEPTH = 4

N_MIXERS = 3
D_FF = 2816
NORM_EPS = 1e-5

GLA_HEADS = 4
GLA_DK = D_MODEL // 2
GLA_DV = D_MODEL
GLA_HEAD_K = GLA_DK // GLA_HEADS
GLA_HEAD_V = GLA_DV // GLA_HEADS
GLA_GATE_RANK = 16
GLA_GATE_NORMALIZER = 16.0
GLA_CHUNK = 64
GLA_IN = 2 * GLA_DK + 2 * GLA_DV + GLA_GATE_RANK

SGU_D_FFN = 6 * D_MODEL
SGU_HALF = SGU_D_FFN // 2
SGU_GROUPS = 8
SGU_GROUP_DIM = SGU_HALF // SGU_GROUPS
SGU_CHUNK = 128

SWA_HEADS = 16
SWA_KV_HEADS = 2
SWA_HEAD_DIM = 64
SWA_GROUP = SWA_HEADS // SWA_KV_HEADS
SWA_WINDOW = 128
SWA_BLOCK = 128
SWA_QKV = (SWA_HEADS + 2 * SWA_KV_HEADS) * SWA_HEAD_DIM
ROPE_DIM = SWA_HEAD_DIM // 4
ROPE_THETA = 500000.0

kernel_name = 'hybrid_gla_sgu_swa_macaron'


def rms_norm(x, gain):
    xf = x.astype(jnp.float32)
    y = xf * lax.rsqrt(jnp.mean(xf * xf, axis=-1, keepdims=True) + NORM_EPS)
    return (y * gain.astype(jnp.float32)).astype(x.dtype)


def layer_norm(x, gain, bias):
    xf = x.astype(jnp.float32)
    mu = jnp.mean(xf, axis=-1, keepdims=True)
    xc = xf - mu
    var = jnp.mean(xc * xc, axis=-1, keepdims=True)
    y = xc * lax.rsqrt(var + NORM_EPS) * gain.astype(jnp.float32) + bias.astype(jnp.float32)
    return y.astype(x.dtype)


def swiglu_ffn(h, w_in, w_out):
    gate, up = jnp.split(h @ w_in, 2, axis=-1)
    return (jax.nn.silu(gate) * up) @ w_out


def gla_mixer(h, w_in, w_gk_up, b_gk, o_norm, w_out):
    B, S, _ = h.shape
    f32 = jnp.float32
    q, k, v, r, gk_low = jnp.split(h @ w_in, [GLA_DK, 2 * GLA_DK, 2 * GLA_DK + GLA_DV, 2 * GLA_DK + 2 * GLA_DV], axis=-1)
    log_a = jax.nn.log_sigmoid((gk_low @ w_gk_up + b_gk).astype(f32)) / GLA_GATE_NORMALIZER
    n = S // GLA_CHUNK

    def to_chunks(t, dh):
        return t.reshape(B, n, GLA_CHUNK, GLA_HEADS, dh).transpose(1, 0, 3, 2, 4).astype(f32)

    q = to_chunks(q, GLA_HEAD_K) * (GLA_HEAD_K ** -0.5)
    k = to_chunks(k, GLA_HEAD_K)
    v = to_chunks(v, GLA_HEAD_V)
    b = jnp.cumsum(to_chunks(log_a, GLA_HEAD_K), axis=3)
    b_last = b[:, :, :, -1:, :]
    q_dec = q * jnp.exp(b)
    k_intra = k * jnp.exp(-b)
    k_state = k * jnp.exp(b_last - b)
    causal = jnp.tril(jnp.ones((GLA_CHUNK, GLA_CHUNK), dtype=bool))
    attn = jnp.where(causal, jnp.einsum('nbhik,nbhjk->nbhij', q_dec, k_intra), 0.0)
    o_intra = jnp.einsum('nbhij,nbhjv->nbhiv', attn, v)

    def step(state, xs):
        q_c, k_c, v_c, decay_c = xs
        o_inter = jnp.einsum('bhik,bhkv->bhiv', q_c, state)
        state = state * decay_c[:, :, 0, :, None] + jnp.einsum('bhjk,bhjv->bhkv', k_c, v_c)
        return state, o_inter

    state0 = jnp.zeros((B, GLA_HEADS, GLA_HEAD_K, GLA_HEAD_V), f32)
    _, o_inter = lax.scan(step, state0, (q_dec, k_state, v, jnp.exp(b_last)))
    o = (o_intra + o_inter).transpose(1, 0, 3, 2, 4).reshape(B, S, GLA_HEADS, GLA_HEAD_V)
    o = rms_norm(o, o_norm).reshape(B, S, GLA_DV) * jax.nn.silu(r.astype(f32))
    return o.astype(h.dtype) @ w_out


def sgu_mixer(h, w_in, ln_gain, ln_bias, w_s, b_s, w_out):
    B, S, _ = h.shape
    u, v = jnp.split(jax.nn.gelu(h @ w_in, approximate=False), 2, axis=-1)
    v = layer_norm(v, ln_gain, ln_bias)
    n = S // SGU_CHUNK
    v = v.reshape(B, n, SGU_CHUNK, SGU_GROUPS, SGU_GROUP_DIM)
    causal = jnp.tril(jnp.ones((SGU_CHUNK, SGU_CHUNK), dtype=bool))
    w_causal = jnp.where(causal[None], w_s, 0.0)
    v = jnp.einsum('gij,bnjgd->bnigd', w_causal.astype(v.dtype), v) + b_s.T[None, None, :, :, None]
    return (u * v.reshape(B, S, SGU_HALF)) @ w_out


def rope_tables(positions):
    inv_freq = ROPE_THETA ** (-jnp.arange(0, ROPE_DIM, 2, dtype=jnp.float32) / ROPE_DIM)
    ang = positions.astype(jnp.float32)[..., None] * inv_freq
    return jnp.cos(ang)[:, :, None, :], jnp.sin(ang)[:, :, None, :]


def rope_partial(t, cos, sin):
    cos = cos.astype(t.dtype)
    sin = sin.astype(t.dtype)
    half = ROPE_DIM // 2
    x1, x2, rest = t[..., :half], t[..., half:ROPE_DIM], t[..., ROPE_DIM:]
    return jnp.concatenate([x1 * cos - x2 * sin, x2 * cos + x1 * sin, rest], axis=-1)


def swa_mixer(h, cos, sin, w_qkv, b_qkv, sinks, w_out, b_out):
    B, S, _ = h.shape
    HD = SWA_HEAD_DIM
    q, k, v = jnp.split(h @ w_qkv + b_qkv, [SWA_HEADS * HD, (SWA_HEADS + SWA_KV_HEADS) * HD], axis=-1)
    q = rope_partial(q.reshape(B, S, SWA_HEADS, HD), cos, sin)
    k = rope_partial(k.reshape(B, S, SWA_KV_HEADS, HD), cos, sin)
    v = v.reshape(B, S, SWA_KV_HEADS, HD)
    n = S // SWA_BLOCK
    qb = q.reshape(B, n, SWA_BLOCK, SWA_KV_HEADS, SWA_GROUP, HD)
    kb = k.reshape(B, n, SWA_BLOCK, SWA_KV_HEADS, HD)
    vb = v.reshape(B, n, SWA_BLOCK, SWA_KV_HEADS, HD)

    def band(t):
        prev = jnp.concatenate([jnp.zeros_like(t[:, :1]), t[:, :-1]], axis=1)
        return jnp.concatenate([prev, t], axis=2)

    k_band, v_band = band(kb), band(vb)
    scores = jnp.einsum('bnqkgd,bnskd->bnkgqs', qb, k_band).astype(jnp.float32) * (HD ** -0.5)
    qi = jnp.arange(SWA_BLOCK)[:, None] + SWA_BLOCK
    kj = jnp.arange(2 * SWA_BLOCK)[None, :]
    delta = qi - kj
    in_window = (delta >= 0) & (delta < SWA_WINDOW)
    not_pad = (jnp.arange(n)[:, None, None] > 0) | (kj >= SWA_BLOCK)[None]
    valid = in_window[None] & not_pad
    scores = jnp.where(valid[None, :, None, None], scores, -jnp.inf)
    sink = jnp.broadcast_to(sinks.astype(jnp.float32).reshape(1, 1, SWA_KV_HEADS, SWA_GROUP, 1, 1), scores.shape[:-1] + (1,))
    probs = jax.nn.softmax(jnp.concatenate([scores, sink], axis=-1), axis=-1)[..., :-1]
    out = jnp.einsum('bnkgqs,bnskd->bnqkgd', probs.astype(v.dtype), v_band)
    return out.reshape(B, S, SWA_HEADS * HD) @ w_out + b_out


def setup_inputs(seed: int = 0) -> dict:
    key = jax.random.key(seed)
    keys = iter(jax.random.split(key, 128))

    def normal(shape, scale):
        return scale * jax.random.normal(next(keys), shape, jnp.float32)

    def gain(dim):
        return 1.0 + normal((dim,), 0.02)

    inp = {}
    inp['x'] = normal((BATCH, SEQ, D_MODEL), 1.0)
    inp['positions'] = jnp.broadcast_to(jnp.arange(SEQ, dtype=jnp.int32), (BATCH, SEQ))

    def ffn(prefix):
        inp[prefix + '_norm'] = gain(D_MODEL)
        inp[prefix + '_w_in'] = normal((D_MODEL, 2 * D_FF), D_MODEL ** -0.5)
        inp[prefix + '_w_out'] = normal((D_FF, D_MODEL), D_FF ** -0.5)

    for layer in range(DEPTH):
        p = 'l%d' % layer
        ffn(p + '_ffn1')
        inp[p + '_mix_norm'] = gain(D_MODEL)
        kind = layer % N_MIXERS
        if kind == 0:
            inp[p + '_gla_w_in'] = normal((D_MODEL, GLA_IN), D_MODEL ** -0.5)
            inp[p + '_gla_w_gk_up'] = normal((GLA_GATE_RANK, GLA_DK), GLA_GATE_RANK ** -0.5)
            inp[p + '_gla_b_gk'] = normal((GLA_DK,), 0.02)
            inp[p + '_gla_o_norm'] = gain(GLA_HEAD_V)
            inp[p + '_gla_w_out'] = normal((GLA_DV, D_MODEL), GLA_DV ** -0.5)
        elif kind == 1:
            inp[p + '_sgu_w_in'] = normal((D_MODEL, SGU_D_FFN), D_MODEL ** -0.5)
            inp[p + '_sgu_ln_gain'] = gain(SGU_HALF)
            inp[p + '_sgu_ln_bias'] = normal((SGU_HALF,), 0.02)
            inp[p + '_sgu_w_s'] = normal((SGU_GROUPS, SGU_CHUNK, SGU_CHUNK), SGU_CHUNK ** -0.5)
            inp[p + '_sgu_b_s'] = 1.0 + normal((SGU_GROUPS, SGU_CHUNK), 0.02)
            inp[p + '_sgu_w_out'] = normal((SGU_HALF, D_MODEL), SGU_HALF ** -0.5)
        else:
            inp[p + '_swa_w_qkv'] = normal((D_MODEL, SWA_QKV), D_MODEL ** -0.5)
            inp[p + '_swa_b_qkv'] = normal((SWA_QKV,), 0.02)
            inp[p + '_swa_sinks'] = normal((SWA_HEADS,), 0.5)
            inp[p + '_swa_w_out'] = normal((SWA_HEADS * SWA_HEAD_DIM, D_MODEL), (SWA_HEADS * SWA_HEAD_DIM) ** -0.5)
            inp[p + '_swa_b_out'] = normal((D_MODEL,), 0.02)
        ffn(p + '_ffn2')
    inp['final_norm'] = gain(D_MODEL)
    return inp


def reference(x, positions,
              l0_ffn1_norm, l0_ffn1_w_in, l0_ffn1_w_out, l0_mix_norm,
              l0_gla_w_in, l0_gla_w_gk_up, l0_gla_b_gk, l0_gla_o_norm, l0_gla_w_out,
              l0_ffn2_norm, l0_ffn2_w_in, l0_ffn2_w_out,
              l1_ffn1_norm, l1_ffn1_w_in, l1_ffn1_w_out, l1_mix_norm,
              l1_sgu_w_in, l1_sgu_ln_gain, l1_sgu_ln_bias, l1_sgu_w_s, l1_sgu_b_s, l1_sgu_w_out,
              l1_ffn2_norm, l1_ffn2_w_in, l1_ffn2_w_out,
              l2_ffn1_norm, l2_ffn1_w_in, l2_ffn1_w_out, l2_mix_norm,
              l2_swa_w_qkv, l2_swa_b_qkv, l2_swa_sinks, l2_swa_w_out, l2_swa_b_out,
              l2_ffn2_norm, l2_ffn2_w_in, l2_ffn2_w_out,
              l3_ffn1_norm, l3_ffn1_w_in, l3_ffn1_w_out, l3_mix_norm,
              l3_gla_w_in, l3_gla_w_gk_up, l3_gla_b_gk, l3_gla_o_norm, l3_gla_w_out,
              l3_ffn2_norm, l3_ffn2_w_in, l3_ffn2_w_out,
              final_norm):
    cos, sin = rope_tables(positions)
    ffn1 = [(l0_ffn1_norm, l0_ffn1_w_in, l0_ffn1_w_out), (l1_ffn1_norm, l1_ffn1_w_in, l1_ffn1_w_out),
            (l2_ffn1_norm, l2_ffn1_w_in, l2_ffn1_w_out), (l3_ffn1_norm, l3_ffn1_w_in, l3_ffn1_w_out)]
    ffn2 = [(l0_ffn2_norm, l0_ffn2_w_in, l0_ffn2_w_out), (l1_ffn2_norm, l1_ffn2_w_in, l1_ffn2_w_out),
            (l2_ffn2_norm, l2_ffn2_w_in, l2_ffn2_w_out), (l3_ffn2_norm, l3_ffn2_w_in, l3_ffn2_w_out)]
    mix_norms = [l0_mix_norm, l1_mix_norm, l2_mix_norm, l3_mix_norm]
    mixers = [
        lambda t: gla_mixer(t, l0_gla_w_in, l0_gla_w_gk_up, l0_gla_b_gk, l0_gla_o_norm, l0_gla_w_out),
        lambda t: sgu_mixer(t, l1_sgu_w_in, l1_sgu_ln_gain, l1_sgu_ln_bias, l1_sgu_w_s, l1_sgu_b_s, l1_sgu_w_out),
        lambda t: swa_mixer(t, cos, sin, l2_swa_w_qkv, l2_swa_b_qkv, l2_swa_sinks, l2_swa_w_out, l2_swa_b_out),
        lambda t: gla_mixer(t, l3_gla_w_in, l3_gla_w_gk_up, l3_gla_b_gk, l3_gla_o_norm, l3_gla_w_out),
    ]
    for i in range(DEPTH):
        n1, wi1, wo1 = ffn1[i]
        n2, wi2, wo2 = ffn2[i]
        x = x + 0.5 * swiglu_ffn(rms_norm(x, n1), wi1, wo1)
        x = x + mixers[i](rms_norm(x, mix_norms[i]))
        x = x + 0.5 * swiglu_ffn(rms_norm(x, n2), wi2, wo2)
    return rms_norm(x, final_norm)
```

```cpp
#include <hip/hip_runtime.h>
#include <hip/hip_cooperative_groups.h>
#include <cstdio>
#include <cstdint>
#include <cmath>
namespace cg = cooperative_groups;
namespace pg8 {
#define PG8_LAS __attribute__((address_space(3)))
#define GAS __attribute__((address_space(1)))
typedef unsigned short bf16_t;
typedef short bf16x8 __attribute__((ext_vector_type(8)));
typedef float f32x4 __attribute__((ext_vector_type(4)));
typedef unsigned u32x4 __attribute__((ext_vector_type(4)));
constexpr int BM = 256, BK = 64, HALF = 128, HTB = HALF * BK * 2  , STAGE_BYTES = 8 * HTB, NXCD = 8, WGM = 8;

__host__ __device__ __forceinline__ int lds_byte(int r, int c) { const int st = (r >> 4) * 2 + (c >> 5), rr = r & 15, cc = c & 31, ob = rr * 64 + cc * 2; return st * 1024 + (ob ^ (((ob >> 9) & 1) << 5)); }
__host__ __device__ __forceinline__ void stage_rc(int b, int& R, int& C) { const int st = b / 1024, sb = b % 1024, swz = sb ^ (((sb >> 9) & 1) << 5); R = (st >> 1) * 16 + swz / 64; C = (st & 1) * 32 + (swz % 64) / 2; }
__host__ __device__ __forceinline__ int perm32(int rho) { const int n = rho >> 4, i = rho & 15; return 8 * (i >> 2) + 4 * n + (i & 3); }

struct Unit { int pm, pn; };
struct Gemm { const GAS bf16_t* A; const GAS bf16_t* Bt; int M, N, K, lda; };

struct StaticOrder {
    int nM, nN, nwg, G, c;
    __host__ __device__ void init(int M, int N, int G_, int c_) { nM = M / BM; nN = N / BM; nwg = nM * nN; G = G_; c = c_; }
    __host__ __device__ bool next(int i, Unit& u) const {
        const long L = (long)i * G + c; if (L >= nwg) return false;
        int wgid = (int)L; { const int q = nwg / NXCD, r = nwg % NXCD, xcd = wgid % NXCD, off = wgid / NXCD; wgid = (xcd < r ? xcd * (q + 1) : r * (q + 1) + (xcd - r) * q) + off; }
        const int nig = WGM * nN, gid = wgid / nig, fm = gid * WGM, gsz = (nM - fm) < WGM ? (nM - fm) : WGM;
        u.pm = fm + ((wgid % nig) % gsz); u.pn = (wgid % nig) / gsz; return true;
    }
    __device__ __forceinline__ void a_ready(const Unit&) const {}
    __device__ __forceinline__ void done(const Unit&) const {}
};


typedef __bf16 bf16v2_t __attribute__((ext_vector_type(2)));
__device__ __forceinline__ unsigned cvt_pk_bf16(float lo, float hi) { bf16v2_t v; v.x = (__bf16)lo; v.y = (__bf16)hi; return __builtin_bit_cast(unsigned, v); }
typedef float f32x2 __attribute__((ext_vector_type(2)));
__device__ __forceinline__ f32x2 gelu_pk(f32x2 v) {
    const f32x2 av = __builtin_elementwise_abs(v), d = av * 0.2316418882f + 1.0f;
    f32x2 t; t.x = __builtin_amdgcn_rcpf(d.x); t.y = __builtin_amdgcn_rcpf(d.y);
    f32x2 q = t * 0.5307027145f + (-0.7265760135f); q = q * t + 0.7107068705f; q = q * t + (-0.142248368f); q = q * t + 0.127414796f; q = q * t;
    const f32x2 s = (v * v) * (-0.72134752044f);
    f32x2 e; e.x = __builtin_amdgcn_exp2f(s.x); e.y = __builtin_amdgcn_exp2f(s.y);
    const f32x2 m = v * (q * e), r = v - m;
    f32x2 o; o.x = v.x < 0.f ? m.x : r.x; o.y = v.y < 0.f ? m.y : r.y; return o;
}
__device__ __forceinline__ float silu_f(float g) { return g * __builtin_amdgcn_rcpf(1.0f + __expf(-g)); }
constexpr float RMS_EPS = 1e-5f;
constexpr int SSQ_M = 32768;
__device__ __forceinline__ float ssq4(const GAS float* p, int r) { const f32x4 v = *(const GAS f32x4*)(p + 4 * (size_t)r); return (v[0] + v[1]) + (v[2] + v[3]); }

struct EpiSwiGLU {
    static constexpr bool PERM = true, AFTER_DRAIN = false;
    GAS bf16_t* H; int ldh; const GAS float* ssq;
    __device__ __forceinline__ void operator()(const f32x4 (&acc)[2][2][4][2], const Unit& u, int wr, int wc, int fr, int fq) const {
        const int row0 = u.pm * BM + wr * 64 + fr, col0 = u.pn * HALF + wc * 32 + 8 * fq;
        float rsv[2][4];
#pragma unroll
        for (int ai = 0; ai < 2; ++ai)
#pragma unroll
            for (int m = 0; m < 4; ++m) rsv[ai][m] = ssq4(ssq, row0 + ai * HALF + m * 16);
#pragma unroll
        for (int ai = 0; ai < 2; ++ai)
#pragma unroll
            for (int m = 0; m < 4; ++m) {
                const int r = row0 + ai * HALF + m * 16;
                const float rs = __builtin_amdgcn_rsqf(rsv[ai][m] * (1.0f / 1024.0f) + RMS_EPS);
                float hv[8], gt[8], ex[8];
#pragma unroll
                for (int k = 0; k < 8; ++k) { gt[k] = acc[ai][0][m][k >> 2][k & 3] * rs; ex[k] = gt[k] * -1.4426950408889634f; }
#pragma unroll
                for (int k = 0; k < 8; ++k) ex[k] = __builtin_amdgcn_exp2f(ex[k]);
#pragma unroll
                for (int k = 0; k < 8; ++k) ex[k] = ex[k] + 1.0f;
#pragma unroll
                for (int k = 0; k < 8; ++k) ex[k] = __builtin_amdgcn_rcpf(ex[k]);
#pragma unroll
                for (int k = 0; k < 8; ++k) hv[k] = (gt[k] * ex[k]) * (acc[ai][1][m][k >> 2][k & 3] * rs);
                u32x4 w; w.x = cvt_pk_bf16(hv[0], hv[1]); w.y = cvt_pk_bf16(hv[2], hv[3]); w.z = cvt_pk_bf16(hv[4], hv[5]); w.w = cvt_pk_bf16(hv[6], hv[7]);
                *(GAS u32x4*)(H + (size_t)r * ldh + col0) = w;
            }
    }
};
__device__ __forceinline__ float bf_lo(unsigned w) { return __builtin_bit_cast(float, w << 16); }
__device__ __forceinline__ float bf_hi(unsigned w) { return __builtin_bit_cast(float, w & 0xffff0000u); }
struct EpiRes {
    static constexpr bool PERM = true, AFTER_DRAIN = false;
    GAS bf16_t* xb; GAS float* ssq_out; const GAS float* bias; float alpha; int row0; PG8_LAS float* red; int tid;
    __device__ __forceinline__ void operator()(const f32x4 (&acc)[2][2][4][2], const Unit& u, int wr, int wc, int fr, int fq) const {
        const int rowb = row0 + u.pm * BM + wr * 64 + fr, col0 = u.pn * BM + wc * 32 + 8 * fq;
        f32x4 bv[2][2];
#pragma unroll
        for (int bj = 0; bj < 2; ++bj)
#pragma unroll
            for (int n = 0; n < 2; ++n) bv[bj][n] = bias ? *(const GAS f32x4*)(bias + col0 + bj * HALF + 4 * n) : (f32x4){0.f, 0.f, 0.f, 0.f};
#pragma unroll
        for (int ai = 0; ai < 2; ++ai) {
            u32x4 xov[4][2];
#pragma unroll
            for (int m = 0; m < 4; ++m)
#pragma unroll
                for (int bj = 0; bj < 2; ++bj) xov[m][bj] = *(const GAS u32x4*)(xb + (size_t)(rowb + ai * HALF + m * 16) * 1024 + col0 + bj * HALF);
#pragma unroll
            for (int m = 0; m < 4; ++m) {
                const int r = rowb + ai * HALF + m * 16; const size_t off = (size_t)r * 1024 + col0; float s = 0.f;
#pragma unroll
                for (int bj = 0; bj < 2; ++bj) {
                    const u32x4 xo = xov[m][bj];
                    const f32x4 o0 = (f32x4){bf_lo(xo.x), bf_hi(xo.x), bf_lo(xo.y), bf_hi(xo.y)}, o1 = (f32x4){bf_lo(xo.z), bf_hi(xo.z), bf_lo(xo.w), bf_hi(xo.w)};
                    const f32x4 v0 = o0 + (acc[ai][bj][m][0] + bv[bj][0]) * alpha, v1 = o1 + (acc[ai][bj][m][1] + bv[bj][1]) * alpha;
                    u32x4 w; w.x = cvt_pk_bf16(v0[0], v0[1]); w.y = cvt_pk_bf16(v0[2], v0[3]); w.z = cvt_pk_bf16(v1[0], v1[1]); w.w = cvt_pk_bf16(v1[2], v1[3]);
                    *(GAS u32x4*)(xb + off + bj * HALF) = w;
                    s += (v0[0] * v0[0] + v0[1] * v0[1]) + (v0[2] * v0[2] + v0[3] * v0[3]) + (v1[0] * v1[0] + v1[1] * v1[1]) + (v1[2] * v1[2] + v1[3] * v1[3]);
                }
                s += __shfl_xor(s, 16); s += __shfl_xor(s, 32);
                if (fq == 0) red[(ai * HALF + wr * 64 + m * 16 + fr) * 4 + wc] = s;
            }
        }
        asm volatile("s_waitcnt lgkmcnt(0)" ::: "memory"); __builtin_amdgcn_s_barrier(); asm volatile("" ::: "memory");
        if (tid < 256) { const f32x4 v = *(const PG8_LAS f32x4*)(red + tid * 4); ssq_out[4 * (size_t)(row0 + u.pm * BM + tid) + u.pn] = (v[0] + v[1]) + (v[2] + v[3]); }
    }
};
struct EpiPlain {
    static constexpr bool PERM = true, AFTER_DRAIN = false;
    GAS bf16_t* O; int ldo; const GAS float* ssq; const GAS float* bias; int act; GAS float* lnstat; int stat_pn0; int row0; PG8_LAS float* red; int tid;
    __device__ __forceinline__ void operator()(const f32x4 (&acc)[2][2][4][2], const Unit& u, int wr, int wc, int fr, int fq) const {
        const int rowl = u.pm * BM + wr * 64 + fr, col0 = u.pn * BM + wc * 32 + 8 * fq;
        const bool dostat = (lnstat != nullptr) && (u.pn >= stat_pn0);
        f32x4 bv[2][2];
#pragma unroll
        for (int bj = 0; bj < 2; ++bj)
#pragma unroll
            for (int n = 0; n < 2; ++n) bv[bj][n] = bias ? *(const GAS f32x4*)(bias + col0 + bj * HALF + 4 * n) : (f32x4){0.f, 0.f, 0.f, 0.f};
        float rsv[2][4];
#pragma unroll
        for (int ai = 0; ai < 2; ++ai)
#pragma unroll
            for (int m = 0; m < 4; ++m) rsv[ai][m] = ssq4(ssq, row0 + rowl + ai * HALF + m * 16);
#pragma unroll
        for (int ai = 0; ai < 2; ++ai)
#pragma unroll
            for (int m = 0; m < 4; ++m) {
                const int rl = rowl + ai * HALF + m * 16, rg = row0 + rl;
                const float rs = __builtin_amdgcn_rsqf(rsv[ai][m] * (1.0f / 1024.0f) + RMS_EPS);
                float s1 = 0.f, s2 = 0.f;
#pragma unroll
                for (int bj = 0; bj < 2; ++bj) {
                    f32x4 v0 = acc[ai][bj][m][0] * rs + bv[bj][0], v1 = acc[ai][bj][m][1] * rs + bv[bj][1];
                    if (act) { const f32x2 a = gelu_pk((f32x2){v0[0], v0[1]}), b = gelu_pk((f32x2){v0[2], v0[3]}), c = gelu_pk((f32x2){v1[0], v1[1]}), d = gelu_pk((f32x2){v1[2], v1[3]});
                        v0 = (f32x4){a.x, a.y, b.x, b.y}; v1 = (f32x4){c.x, c.y, d.x, d.y}; }
                    u32x4 w; w.x = cvt_pk_bf16(v0[0], v0[1]); w.y = cvt_pk_bf16(v0[2], v0[3]); w.z = cvt_pk_bf16(v1[0], v1[1]); w.w = cvt_pk_bf16(v1[2], v1[3]);
                    *(GAS u32x4*)(O + (size_t)rl * ldo + col0 + bj * HALF) = w;
                    s1 += (v0[0] + v0[1]) + (v0[2] + v0[3]) + (v1[0] + v1[1]) + (v1[2] + v1[3]);
                    s2 += (v0[0] * v0[0] + v0[1] * v0[1]) + (v0[2] * v0[2] + v0[3] * v0[3]) + (v1[0] * v1[0] + v1[1] * v1[1]) + (v1[2] * v1[2] + v1[3] * v1[3]);
                }
                if (dostat) {
                    s1 += __shfl_xor(s1, 16); s1 += __shfl_xor(s1, 32); s2 += __shfl_xor(s2, 16); s2 += __shfl_xor(s2, 32);
                    if (fq == 0) { red[(rl - u.pm * BM) * 4 + wc] = s1; red[1024 + (rl - u.pm * BM) * 4 + wc] = s2; }
                }
            }
        if (dostat) {
            asm volatile("s_waitcnt lgkmcnt(0)" ::: "memory"); __builtin_amdgcn_s_barrier(); asm volatile("" ::: "memory");
            if (tid < 256) { const f32x4 a = *(const PG8_LAS f32x4*)(red + tid * 4), b = *(const PG8_LAS f32x4*)(red + 1024 + tid * 4);
                f32x2 o; o.x = (a[0] + a[1]) + (a[2] + a[3]); o.y = (b[0] + b[1]) + (b[2] + b[3]);
                *(GAS f32x2*)(lnstat + 24 * (size_t)(row0 + u.pm * BM + tid) + 2 * (u.pn - stat_pn0)) = o; }
        }
    }
};

template <class Epi, class Sched, bool ALIGN_EPI = false, bool SP2 = false>
__device__ __forceinline__ void gemm_phase(PG8_LAS unsigned char* lds, const Gemm g, const Sched& S, const Epi& E, const int tid) {
    const int wid = __builtin_amdgcn_readfirstlane(tid >> 6), lane = tid & 63, wr = wid >> 2, wc = wid & 3, fr = lane & 15, fq = lane >> 4;
    const int K = g.K, nt = K / BK;
    unsigned voffA[2], voffB[2];
#pragma unroll
    for (int i = 0; i < 2; ++i) { int R, C; stage_rc(tid * 16 + i * 8192, R, C); const int Rb = Epi::PERM ? ((R & ~31) + perm32(R & 31)) : R;
        voffA[i] = (unsigned)(R * g.lda + C) * 2u; voffB[i] = (unsigned)(Rb * K + C) * 2u; }
    const size_t kstep = (size_t)(BK * 2);
    const size_t hstepA = (size_t)HALF * g.lda * 2, hstepB = (size_t)HALF * K * 2;
    const size_t tstepA = 2 * hstepA, tstepB = 2 * hstepB;
    const unsigned ldsw = (unsigned)wid * 1024u;
    const int aoff = lds_byte(wr * 64 + fr, fq * 8), boff = lds_byte(wc * 32 + fr, fq * 8);
#define PG8_SA(b, h) (((b) * 2 + (h)) * HTB)
#define PG8_SB(b, h) ((4 + (b) * 2 + (h)) * HTB)
#define PG8_STAGE(bufoff, gbase, voff) do { _Pragma("unroll") for (int _i = 0; _i < 2; ++_i) \
        __builtin_amdgcn_global_load_lds((const GAS unsigned*)((const GAS char*)(gbase) + (voff)[_i]), (PG8_LAS unsigned*)(lds + (bufoff) + ldsw + _i * 8192), 16, 0, 0); } while (0)
#define PG8_LDA(dst, b, h) do { _Pragma("unroll") for (int m = 0; m < 4; ++m) _Pragma("unroll") for (int k = 0; k < 2; ++k) dst[m][k] = *(const PG8_LAS bf16x8*)(lds + PG8_SA(b, h) + aoff + m * 2048 + k * 1024); } while (0)
#define PG8_LDB(dst, b, h) do { _Pragma("unroll") for (int n = 0; n < 2; ++n) _Pragma("unroll") for (int k = 0; k < 2; ++k) dst[n][k] = *(const PG8_LAS bf16x8*)(lds + PG8_SB(b, h) + boff + n * 2048 + k * 1024); } while (0)
#define PG8_MMA(ai, bj, At, Bt) do { __builtin_amdgcn_s_setprio(1); _Pragma("unroll") for (int m = 0; m < 4; ++m) _Pragma("unroll") for (int n = 0; n < 2; ++n) _Pragma("unroll") for (int k = 0; k < 2; ++k) \
        acc[ai][bj][m][n] = __builtin_amdgcn_mfma_f32_16x16x32_bf16(Bt[n][k], At[m][k], acc[ai][bj][m][n], 0, 0, 0); __builtin_amdgcn_s_setprio(0); } while (0)
#define PG8_WAIT_V(n) asm volatile("s_waitcnt vmcnt(" #n ")" ::: "memory")
#define PG8_WAIT_L(n) asm volatile("s_waitcnt lgkmcnt(" #n ")" ::: "memory")
#define PG8_BAR __builtin_amdgcn_s_barrier()
#define PG8_SCHED __builtin_amdgcn_sched_barrier(0)
    Unit cur, nxt; int ui = 0;
    if (!S.next(0, cur)) return;
    f32x4 acc[2][2][4][2];
#pragma unroll
    for (int a = 0; a < 2; ++a)
#pragma unroll
        for (int b = 0; b < 2; ++b)
#pragma unroll
            for (int m = 0; m < 4; ++m)
#pragma unroll
                for (int n = 0; n < 2; ++n) acc[a][b][m][n] = (f32x4){0.f, 0.f, 0.f, 0.f};
    bf16x8 At[4][2], B0[2][2], B1[2][2];
    const GAS char* cA = (const GAS char*)g.A + (size_t)cur.pm * tstepA; const GAS char* cB = (const GAS char*)g.Bt + (size_t)cur.pn * tstepB;
    S.a_ready(cur);
    if constexpr (SP2) {
        PG8_STAGE(PG8_SB(0, 0), cB, voffB); PG8_STAGE(PG8_SB(0, 1), cB + hstepB, voffB); PG8_STAGE(PG8_SA(0, 0), cA, voffA); PG8_STAGE(PG8_SA(0, 1), cA + hstepA, voffA);
        if (wr == 1) PG8_BAR;
        PG8_WAIT_V(2); PG8_BAR;
        PG8_STAGE(PG8_SB(1, 0), cB + kstep, voffB); PG8_STAGE(PG8_SA(1, 0), cA + kstep, voffA); PG8_STAGE(PG8_SB(1, 1), cB + hstepB + kstep, voffB);
        PG8_WAIT_V(6); PG8_BAR;
    } else {
        PG8_STAGE(PG8_SB(0, 0), cB, voffB); PG8_STAGE(PG8_SA(0, 0), cA, voffA); PG8_STAGE(PG8_SB(0, 1), cB + hstepB, voffB); PG8_STAGE(PG8_SA(0, 1), cA + hstepA, voffA);
        if (wr == 1) PG8_BAR;
        PG8_WAIT_V(4); PG8_BAR;
        PG8_STAGE(PG8_SB(1, 0), cB + kstep, voffB); PG8_STAGE(PG8_SA(1, 0), cA + kstep, voffA); PG8_STAGE(PG8_SB(1, 1), cB + hstepB + kstep, voffB);
        PG8_WAIT_V(6); PG8_BAR;
    }
    for (;;) {
        const bool has_next = S.next(ui + 1, nxt);
        const GAS char* nA = has_next ? (const GAS char*)g.A + (size_t)nxt.pm * tstepA : cA; const GAS char* nB = has_next ? (const GAS char*)g.Bt + (size_t)nxt.pn * tstepB : cB;
        for (int t = 0; t < nt; t += 2) {
            const bool last = (t == nt - 2);
            const GAS char* a1 = cA + (size_t)(t + 1) * kstep;
            const GAS char* a2 = last ? nA : cA + (size_t)(t + 2) * kstep; const GAS char* b2 = last ? nB : cB + (size_t)(t + 2) * kstep;
            const GAS char* a3 = a2 + kstep; const GAS char* b3 = b2 + kstep;
            if (last && has_next) S.a_ready(nxt);
            if constexpr (SP2) {
            PG8_LDB(B0, 0, 0); PG8_LDB(B1, 0, 1); PG8_SCHED; PG8_LDA(At, 0, 0); PG8_STAGE(PG8_SA(1, 1), a1 + hstepA, voffA);
            PG8_WAIT_V(8); PG8_WAIT_L(0); PG8_BAR; PG8_MMA(0, 0, At, B0); PG8_MMA(0, 1, At, B1); PG8_BAR; PG8_SCHED;
            PG8_LDA(At, 0, 1); PG8_STAGE(PG8_SB(0, 0), b2, voffB); PG8_STAGE(PG8_SB(0, 1), b2 + hstepB, voffB); PG8_STAGE(PG8_SA(0, 0), a2, voffA);
            PG8_WAIT_V(8); PG8_WAIT_L(0); PG8_BAR; PG8_MMA(1, 0, At, B0); PG8_MMA(1, 1, At, B1); PG8_BAR; PG8_SCHED;
            PG8_LDB(B0, 1, 0); PG8_LDB(B1, 1, 1); PG8_SCHED; PG8_LDA(At, 1, 0); PG8_STAGE(PG8_SA(0, 1), a2 + hstepA, voffA);
            PG8_WAIT_V(8); PG8_WAIT_L(0); PG8_BAR; PG8_MMA(0, 0, At, B0); PG8_MMA(0, 1, At, B1); PG8_BAR; PG8_SCHED;
            PG8_LDA(At, 1, 1); PG8_STAGE(PG8_SB(1, 0), b3, voffB); PG8_STAGE(PG8_SB(1, 1), b3 + hstepB, voffB); PG8_STAGE(PG8_SA(1, 0), a3, voffA);
            PG8_WAIT_V(8); PG8_WAIT_L(0); PG8_BAR; PG8_MMA(1, 0, At, B0); PG8_MMA(1, 1, At, B1); PG8_BAR; PG8_SCHED;
            } else {
            PG8_LDB(B0, 0, 0); PG8_SCHED; PG8_LDA(At, 0, 0); PG8_STAGE(PG8_SA(1, 1), a1 + hstepA, voffA);
            PG8_WAIT_L(8); PG8_BAR; PG8_WAIT_L(0); PG8_MMA(0, 0, At, B0); PG8_BAR; PG8_SCHED;
            PG8_LDB(B1, 0, 1); PG8_STAGE(PG8_SB(0, 0), b2, voffB);
            PG8_BAR; PG8_WAIT_L(0); PG8_MMA(0, 1, At, B1); PG8_BAR;
            PG8_LDA(At, 0, 1); PG8_STAGE(PG8_SA(0, 0), a2, voffA);
            PG8_BAR; PG8_WAIT_L(0); PG8_MMA(1, 0, At, B0); PG8_BAR; PG8_SCHED;
            PG8_STAGE(PG8_SB(0, 1), b2 + hstepB, voffB);
            PG8_WAIT_V(6); PG8_BAR; PG8_MMA(1, 1, At, B1); PG8_BAR;
            PG8_LDB(B0, 1, 0); PG8_SCHED; PG8_LDA(At, 1, 0); PG8_STAGE(PG8_SA(0, 1), a2 + hstepA, voffA);
            PG8_WAIT_L(8); PG8_BAR; PG8_WAIT_L(0); PG8_MMA(0, 0, At, B0); PG8_BAR; PG8_SCHED;
            PG8_LDB(B1, 1, 1); PG8_STAGE(PG8_SB(1, 0), b3, voffB);
            PG8_BAR; PG8_WAIT_L(0); PG8_MMA(0, 1, At, B1); PG8_BAR;
            PG8_LDA(At, 1, 1); PG8_STAGE(PG8_SA(1, 0), a3, voffA);
            PG8_BAR; PG8_WAIT_L(0); PG8_MMA(1, 0, At, B0); PG8_BAR; PG8_SCHED;
            PG8_STAGE(PG8_SB(1, 1), b3 + hstepB, voffB);
            PG8_WAIT_V(6); PG8_BAR; PG8_MMA(1, 1, At, B1); PG8_BAR;
            }
        }
        if constexpr (ALIGN_EPI) { if (wr == 0) PG8_BAR; }
        if constexpr (!Epi::AFTER_DRAIN) { E(acc, cur, wr, wc, fr, fq); S.done(cur); }
        if (!has_next) break;
#pragma unroll
        for (int a = 0; a < 2; ++a)
#pragma unroll
            for (int b = 0; b < 2; ++b)
#pragma unroll
                for (int m = 0; m < 4; ++m)
#pragma unroll
                    for (int n = 0; n < 2; ++n) acc[a][b][m][n] = (f32x4){0.f, 0.f, 0.f, 0.f};
        cur = nxt; cA = nA; cB = nB; ++ui;
        if constexpr (ALIGN_EPI) { if (wr == 1) PG8_BAR; }
    }
    PG8_WAIT_V(0);
    if constexpr (!ALIGN_EPI) { if (wr == 0) PG8_BAR; }
    PG8_BAR;
    if constexpr (Epi::AFTER_DRAIN) { E.fused(acc, cur, wr, wc, fr, fq, lds, wid, lane); S.done(cur); }
#undef PG8_SA
#undef PG8_SB
#undef PG8_STAGE
#undef PG8_LDA
#undef PG8_LDB
#undef PG8_MMA
#undef PG8_WAIT_V
#undef PG8_WAIT_L
#undef PG8_BAR
#undef PG8_SCHED
}
}

#define LAS __attribute__((address_space(3)))
typedef pg8::bf16_t bf16_t;
typedef pg8::bf16x8 bf16x8;
typedef pg8::f32x4 f32x4;
typedef pg8::u32x4 u32x4;
typedef unsigned u32x2 __attribute__((ext_vector_type(2)));
using pg8::cvt_pk_bf16;

constexpr int DM = 1024, SEQL = 4096, NBATCH = 8, MROWS = NBATCH * SEQL, DFF = 2816;
constexpr int LDS_BYTES = 147456;
constexpr size_t SZ_FFN_IN = (size_t)5632 * 1024 * 2, SZ_FFN_OUT = (size_t)1024 * 2816 * 2, SZ_FFN = SZ_FFN_IN + SZ_FFN_OUT;
constexpr size_t SZ_GLA_IN = (size_t)3328 * 1024 * 2, SZ_GLA_OUT = (size_t)1024 * 1024 * 2, SZ_GLA = SZ_GLA_IN + SZ_GLA_OUT;
constexpr size_t SZ_SGU_IN = (size_t)6144 * 1024 * 2, SZ_SGU_OUT = (size_t)1024 * 3072 * 2;
constexpr size_t SZ_SWA_IN = (size_t)1280 * 1024 * 2, SZ_SWA_OUT = (size_t)1024 * 1024 * 2;
constexpr size_t WS_FFN = 0;
constexpr size_t WS_GLA = WS_FFN + 8 * SZ_FFN;
constexpr size_t WS_SGU = WS_GLA + 2 * SZ_GLA;
constexpr size_t WS_SWA = WS_SGU + SZ_SGU_IN + SZ_SGU_OUT;
constexpr size_t WS_XB = WS_SWA + SZ_SWA_IN + SZ_SWA_OUT;
constexpr size_t WS_TEMP = WS_XB + (size_t)MROWS * 1024 * 2;
constexpr size_t SZ_TEMP = (size_t)MROWS * 3328 * 2;
constexpr size_t WS_SSQ = WS_TEMP + SZ_TEMP;
constexpr size_t WS_LNSTAT = WS_SSQ + 13 * 4 * (size_t)MROWS * 4;
constexpr size_t WS_ROPE = WS_LNSTAT + (size_t)MROWS * 24 * 4;
constexpr size_t WS_DEC = WS_ROPE + (size_t)MROWS * 16 * 4;
constexpr size_t WS_END = WS_DEC + 16 * (size_t)MROWS * 4 * 4;
constexpr size_t WS_BAR = WS_END, WS_BAR_BYTES = 16384, WS_KST = WS_BAR + WS_BAR_BYTES, WS_PBUF = WS_KST + (size_t)2048 * 8192 * 2, WS_END2 = WS_PBUF + (size_t)2048 * 4096 * 2;
static_assert(WS_END2 <= (size_t)512 * 1024 * 1024, "workspace map");

struct Args { const float* in[52]; float* out; unsigned char* ws; };

__device__ __forceinline__ float bf2f(unsigned v) { return __builtin_bit_cast(float, v << 16); }
__device__ __forceinline__ float bflo(unsigned w) { return __builtin_bit_cast(float, w << 16); }
__device__ __forceinline__ float bfhi(unsigned w) { return __builtin_bit_cast(float, w & 0xffff0000u); }
__device__ __forceinline__ bf16_t f2bf(float f) { return __builtin_bit_cast(bf16_t, (__bf16)f); }
__device__ __forceinline__ f32x4 mfma16(bf16x8 a, bf16x8 b, f32x4 c) { return __builtin_amdgcn_mfma_f32_16x16x32_bf16(a, b, c, 0, 0, 0); }
__device__ __forceinline__ float wave_sum(float v) {
#pragma unroll
    for (int o = 1; o < 64; o <<= 1) v += __shfl_xor(v, o);
    return v;
}
__device__ __forceinline__ int layer_base(int L) { return L == 0 ? 2 : (L == 1 ? 14 : (L == 2 ? 27 : 39)); }
__device__ __forceinline__ GAS unsigned char* mixer_w(GAS unsigned char* ws, int L) { return ws + (L == 0 ? WS_GLA : (L == 3 ? WS_GLA + SZ_GLA : (L == 1 ? WS_SGU : WS_SWA))); }
__device__ __forceinline__ size_t mixer_in_sz(int L) { return L == 1 ? SZ_SGU_IN : (L == 2 ? SZ_SWA_IN : SZ_GLA_IN); }

typedef const __attribute__((address_space(4))) unsigned long long* KPTR;
#define ARGP(i) ((const GAS float*)kp[i])
struct MatDesc { const GAS float* src; const GAS float* gain; GAS bf16_t* dst; int K, N, mode; };
__device__ __forceinline__ MatDesc get_mat(KPTR kp, GAS unsigned char* ws, int mat) {
    const int L = mat / 6, j = mat % 6, base = layer_base(L), f2 = base + (L == 1 ? 10 : 9);
    MatDesc d;
    if (j == 0)      { d.src = ARGP(base + 1); d.gain = ARGP(base); d.dst = (GAS bf16_t*)(ws + WS_FFN + (size_t)(L * 2) * SZ_FFN); d.K = 1024; d.N = 5632; d.mode = 1; }
    else if (j == 1) { d.src = ARGP(base + 2); d.gain = nullptr;    d.dst = (GAS bf16_t*)(ws + WS_FFN + (size_t)(L * 2) * SZ_FFN + SZ_FFN_IN); d.K = 2816; d.N = 1024; d.mode = 0; }
    else if (j == 2) { d.src = ARGP(f2 + 1);   d.gain = ARGP(f2);   d.dst = (GAS bf16_t*)(ws + WS_FFN + (size_t)(L * 2 + 1) * SZ_FFN); d.K = 1024; d.N = 5632; d.mode = 1; }
    else if (j == 3) { d.src = ARGP(f2 + 2);   d.gain = nullptr;    d.dst = (GAS bf16_t*)(ws + WS_FFN + (size_t)(L * 2 + 1) * SZ_FFN + SZ_FFN_IN); d.K = 2816; d.N = 1024; d.mode = 0; }
    else if (j == 4) { d.src = ARGP(base + 4); d.gain = ARGP(base + 3); d.dst = (GAS bf16_t*)mixer_w(ws, L); d.K = 1024; d.N = (L == 1 ? 6144 : (L == 2 ? 1280 : 3088)); d.mode = 0; }
    else             { d.src = ARGP(base + (L == 1 ? 9 : (L == 2 ? 7 : 8))); d.gain = nullptr; d.dst = (GAS bf16_t*)(mixer_w(ws, L) + mixer_in_sz(L)); d.K = (L == 1 ? 3072 : 1024); d.N = 1024; d.mode = 0; }
    return d;
}
__device__ __forceinline__ int mat_items(int mat) {
    const int L = mat / 6, j = mat % 6;
    if (j == 0 || j == 2) return 16 * 88;
    if (j == 1 || j == 3) return 44 * 16;
    if (j == 4) return 16 * (L == 1 ? 96 : (L == 2 ? 20 : 49));
    return (L == 1 ? 48 : 16) * 16;
}
__device__ __forceinline__ void p0_transpose_item(const MatDesc& d, LAS float* scr, int item, int lane) {
    const int nblk = (d.N + 63) / 64, kb = item / nblk, nb = item % nblk, k0 = 64 * kb, n0 = 64 * nb, K = d.K, N = d.N;
    const int c4 = (lane & 15) * 4, r0 = lane >> 4, nn = n0 + c4;
    f32x4 v[16];
#pragma unroll
    for (int i = 0; i < 16; ++i) v[i] = (nn < N) ? *(const GAS f32x4*)(d.src + (size_t)(k0 + r0 + 4 * i) * N + nn) : (f32x4){0.f, 0.f, 0.f, 0.f};
    if (d.gain) {
#pragma unroll
        for (int i = 0; i < 16; ++i) v[i] = v[i] * d.gain[k0 + r0 + 4 * i]; }
#pragma unroll
    for (int i = 0; i < 16; ++i) { LAS float* p = scr + (r0 + 4 * i) * 65 + c4; p[0] = v[i][0]; p[1] = v[i][1]; p[2] = v[i][2]; p[3] = v[i][3]; }
    asm volatile("s_waitcnt lgkmcnt(0)" ::: "memory");
#pragma unroll
    for (int j = 0; j < 8; ++j) { const int id = lane + 64 * j, n = id >> 3, c = id & 7; const LAS float* sp = scr + (8 * c) * 65 + n;
        u32x4 o; o.x = cvt_pk_bf16(sp[0 * 65], sp[1 * 65]); o.y = cvt_pk_bf16(sp[2 * 65], sp[3 * 65]); o.z = cvt_pk_bf16(sp[4 * 65], sp[5 * 65]); o.w = cvt_pk_bf16(sp[6 * 65], sp[7 * 65]);
        const int ng = n0 + n; int row = ng;
        if (d.mode == 1) { row = (ng < 2816) ? ((ng >> 7) * 256 + (ng & 127)) : ((((ng - 2816) >> 7) * 256) + 128 + ((ng - 2816) & 127)); }
        *(GAS u32x4*)(d.dst + (size_t)row * K + k0 + 8 * c) = o; }
    asm volatile("s_waitcnt lgkmcnt(0)" ::: "memory");
}
__device__ __forceinline__ void p0_prologue(KPTR kp, GAS unsigned char* ws_, LAS unsigned char* lds, const int tid) {
    const int lane = tid & 63, wave = tid >> 6, G = gridDim.x;
    const int gw = blockIdx.x * 8 + wave, NGW = G * 8;
    const size_t gt = (size_t)blockIdx.x * 512 + tid, NGT = (size_t)G * 512;
    LAS float* scr = (LAS float*)(lds + wave * 16640);
    int total = 0;
    for (int m = 0; m < 24; ++m) total += mat_items(m);
    for (int it = gw; it < total; it += NGW) {
        int r = it, m = 0;
        for (; m < 23; ++m) { const int c = mat_items(m); if (r < c) break; r -= c; }
        const MatDesc d = get_mat(kp, ws_, m);
        p0_transpose_item(d, scr, r, lane);
    }
    for (size_t i = gt; i < 2 * (size_t)240 * 1024 / 8; i += NGT) { const int which = (int)(i / (240 * 128)); const size_t o = i % (240 * 128);
        *(GAS u32x4*)(ws_ + WS_GLA + (size_t)which * SZ_GLA + (size_t)3088 * 2048 + o * 16) = (u32x4){0u, 0u, 0u, 0u}; }
    { const GAS float* x = ARGP(0); GAS bf16_t* xb = (GAS bf16_t*)(ws_ + WS_XB); GAS float* ssq0 = (GAS float*)(ws_ + WS_SSQ);
      for (int r = gw; r < MROWS; r += NGW) {
        const GAS f32x4* xr = (const GAS f32x4*)(x + (size_t)r * 1024) + lane; float s = 0.f;
        GAS u32x2* o8 = (GAS u32x2*)(xb + (size_t)r * 1024) + lane;
#pragma unroll
        for (int j = 0; j < 4; ++j) { const f32x4 v = xr[64 * j]; s += (v[0] * v[0] + v[1] * v[1]) + (v[2] * v[2] + v[3] * v[3]);
            u32x2 w; w.x = cvt_pk_bf16(v[0], v[1]); w.y = cvt_pk_bf16(v[2], v[3]); o8[64 * j] = w; }
        s = wave_sum(s); if (lane < 4) ssq0[4 * (size_t)r + lane] = (lane == 0) ? s : 0.f; } }
    { const GAS int* pos = (const GAS int*)ARGP(1); GAS float* rope = (GAS float*)(ws_ + WS_ROPE);
      for (size_t i = gt; i < (size_t)MROWS * 8; i += NGT) { const int t = (int)(i >> 3), f = (int)(i & 7);
        const float inv = powf(500000.0f, -(float)f * 0.125f); const float ang = (float)pos[t] * inv;
        rope[(size_t)t * 16 + f] = cosf(ang); rope[(size_t)t * 16 + 8 + f] = sinf(ang); } }
}

__device__ __forceinline__ void gla_pre(LAS unsigned char* lds, GAS bf16_t* proj, GAS bf16_t* kst, GAS float* decb, GAS bf16_t* pbuf, const GAS float* w_up, const GAS float* b_gk, const int tid) {
    constexpr int QST = 136;
    const int lane = tid & 63, wave = tid >> 6, l15 = lane & 15, g4 = lane >> 4;
    LAS bf16_t* QD = (LAS bf16_t*)lds;
    LAS bf16_t* KI = QD + 64 * QST;
    LAS float* SEG = (LAS float*)(KI + 64 * QST);
    LAS float* GKS = SEG + 512;
    const int kch = tid & 127, jq = tid >> 7, mi = wave & 3, half = wave >> 2;
    for (int item = blockIdx.x; item < 2048; item += gridDim.x) {
        const int c = item & 63, h = (item >> 6) & 3, b = item >> 8;
        const size_t t0 = (size_t)b * SEQL + (size_t)c * 64;
        float wup[16];
#pragma unroll
        for (int r = 0; r < 16; ++r) wup[r] = w_up[r * 512 + h * 128 + kch];
        const float bg = b_gk[h * 128 + kch];
        u32x4 graw = (u32x4){0u, 0u, 0u, 0u};
        if (tid < 128) graw = *(const GAS u32x4*)(proj + (t0 + (tid >> 1)) * 3328 + 3072 + (tid & 1) * 8);
        u32x4 qraw[2], kraw[2];
#pragma unroll
        for (int q = 0; q < 2; ++q) { const int id = tid + 512 * q; const GAS bf16_t* rp = proj + (t0 + (id >> 4)) * 3328 + h * 128 + (id & 15) * 8; qraw[q] = *(const GAS u32x4*)rp; kraw[q] = *(const GAS u32x4*)(rp + 512); }
        __syncthreads();
        if (tid < 128) { const int j = tid >> 1, hf = tid & 1; LAS float* gd = GKS + j * 16 + hf * 8;
            gd[0] = bflo(graw.x); gd[1] = bfhi(graw.x); gd[2] = bflo(graw.y); gd[3] = bfhi(graw.y); gd[4] = bflo(graw.z); gd[5] = bfhi(graw.z); gd[6] = bflo(graw.w); gd[7] = bfhi(graw.w); }
#pragma unroll
        for (int q = 0; q < 2; ++q) { const int id = tid + 512 * q; *(LAS u32x4*)(QD + (id >> 4) * QST + (id & 15) * 8) = qraw[q]; *(LAS u32x4*)(KI + (id >> 4) * QST + (id & 15) * 8) = kraw[q]; }
        asm volatile("s_waitcnt vmcnt(0)" ::: "memory");
        __syncthreads();
        float la[16]; float run = 0.f;
#pragma unroll
        for (int jj = 0; jj < 16; ++jj) { const LAS float* gr = GKS + (jq * 16 + jj) * 16; float z = bg;
#pragma unroll
            for (int r = 0; r < 16; ++r) z += gr[r] * wup[r];
            const float ls = fminf(z, 0.f) - __logf(1.0f + __expf(-fabsf(z)));
            run += ls * (1.0f / 16.0f); la[jj] = run; }
        SEG[jq * 128 + kch] = run;
        __syncthreads();
        const float s0 = SEG[kch], s1 = SEG[128 + kch], s2 = SEG[256 + kch], s3 = SEG[384 + kch];
        const float pre = (jq > 0 ? s0 : 0.f) + (jq > 1 ? s1 : 0.f) + (jq > 2 ? s2 : 0.f), tot = (s0 + s1) + (s2 + s3);
        unsigned ksp[8];
#pragma unroll
        for (int jj = 0; jj < 16; jj += 2) {
            float ksv[2];
#pragma unroll
            for (int e = 0; e < 2; ++e) { const int j = jq * 16 + jj + e; const float bb = la[jj + e] + pre; const float qf = bf2f(QD[j * QST + kch]), kf = bf2f(KI[j * QST + kch]);
                const bf16_t qd = f2bf(qf * 0.08838834764831845f * __expf(bb)), ki = f2bf(kf * __expf(-bb)); ksv[e] = kf * __expf(tot - bb);
                QD[j * QST + kch] = qd; KI[j * QST + kch] = ki; }
            ksp[jj >> 1] = cvt_pk_bf16(ksv[0], ksv[1]); }
        { GAS u32x4* kd = (GAS u32x4*)(kst + (size_t)item * 8192 + kch * 64 + jq * 16); kd[0] = (u32x4){ksp[0], ksp[1], ksp[2], ksp[3]}; kd[1] = (u32x4){ksp[4], ksp[5], ksp[6], ksp[7]}; }
        if (jq == 0) decb[(size_t)item * 128 + kch] = __expf(tot);
        __syncthreads();
#pragma unroll
        for (int q = 0; q < 2; ++q) { const int id = tid + 512 * q; *(GAS u32x4*)(proj + (t0 + (id >> 4)) * 3328 + h * 128 + (id & 15) * 8) = *(const LAS u32x4*)(QD + (id >> 4) * QST + (id & 15) * 8); }
        f32x4 at[2] = {(f32x4){0.f, 0.f, 0.f, 0.f}, (f32x4){0.f, 0.f, 0.f, 0.f}};
#pragma unroll
        for (int ks = 0; ks < 4; ++ks) {
            const bf16x8 af = *(const LAS bf16x8*)(QD + (mi * 16 + l15) * QST + ks * 32 + 8 * g4);
#pragma unroll
            for (int t = 0; t < 2; ++t) { const bf16x8 bfr = *(const LAS bf16x8*)(KI + ((half * 2 + t) * 16 + l15) * QST + ks * 32 + 8 * g4); at[t] = mfma16(af, bfr, at[t]); }
        }
#pragma unroll
        for (int t = 0; t < 2; ++t)
#pragma unroll
            for (int r = 0; r < 4; ++r) { const int i = mi * 16 + g4 * 4 + r, j = (half * 2 + t) * 16 + l15; pbuf[(size_t)item * 4096 + i * 64 + j] = f2bf(j <= i ? at[t][r] : 0.f); }
    }
}
__device__ __forceinline__ void gla_core(LAS unsigned char* lds, const GAS bf16_t* proj, const GAS bf16_t* kst, const GAS float* decb, const GAS bf16_t* pbuf, GAS bf16_t* ost, const int tid) {
    const int lane = tid & 63, wave = tid >> 6, l15 = lane & 15, g4 = lane >> 4;
    constexpr int QST = 136, JST = 72;
    constexpr int OFF_PS = 64 * QST, OFF_KST = OFF_PS + 64 * JST, OFF_VT = OFF_KST + 128 * JST, OFF_DEC = OFF_VT + 32 * JST, BUF_EL = OFF_DEC + 256;
    LAS bf16_t* BUF = (LAS bf16_t*)lds;
    LAS bf16_t* STT = BUF + 2 * BUF_EL;
    const int mi = wave & 3, half = wave >> 2;
    for (int item = blockIdx.x; item < 256; item += gridDim.x) {
        int vs, bh;
        if (gridDim.x == 256) { vs = item >> 5; bh = (item & 7) * 4 + ((item >> 3) & 3); } else { vs = item & 7; bh = item >> 3; }
        const int h = bh & 3, b = bh >> 2; const size_t oitem = (size_t)(bh * 8 + vs);
        f32x4 st[2] = {(f32x4){0.f, 0.f, 0.f, 0.f}, (f32x4){0.f, 0.f, 0.f, 0.f}};
        __syncthreads();
        for (int i = tid; i < 32 * QST / 2; i += 512) ((LAS unsigned*)STT)[i] = 0u;
        u32x4 rq[2], rs[2], rp, rv = (u32x4){0u, 0u, 0u, 0u}; float rd = 0.f;
#define GLA_LOAD(cn) do { const size_t tn = (size_t)b * SEQL + (size_t)(cn) * 64; const size_t ci = (size_t)((b * 4 + h) * 64 + (cn)); \
            _Pragma("unroll") for (int q = 0; q < 2; ++q) { const int id = tid + 512 * q; \
                rq[q] = *(const GAS u32x4*)(proj + (tn + (id >> 4)) * 3328 + h * 128 + (id & 15) * 8); rs[q] = *(const GAS u32x4*)(kst + ci * 8192 + (size_t)id * 8); } \
            rp = *(const GAS u32x4*)(pbuf + ci * 4096 + (size_t)tid * 8); \
            if (tid < 256) rv = *(const GAS u32x4*)(proj + (tn + (tid >> 2)) * 3328 + 1024 + h * 256 + vs * 32 + (tid & 3) * 8); \
            if (tid < 128) rd = decb[ci * 128 + tid]; } while (0)
        GLA_LOAD(0);
        for (int c = 0; c < 64; ++c) {
            LAS bf16_t* QD = BUF + (c & 1) * BUF_EL; LAS bf16_t* PS = QD + OFF_PS; LAS bf16_t* KST = QD + OFF_KST; LAS bf16_t* VT = QD + OFF_VT; LAS float* DEC = (LAS float*)(QD + OFF_DEC);
            const LAS bf16_t* STR = STT + (c & 1) * 32 * QST; LAS bf16_t* STW = STT + ((c + 1) & 1) * 32 * QST;
#pragma unroll
            for (int q = 0; q < 2; ++q) { const int id = tid + 512 * q;
                *(LAS u32x4*)(QD + (id >> 4) * QST + (id & 15) * 8) = rq[q]; *(LAS u32x4*)(KST + (id >> 3) * JST + (id & 7) * 8) = rs[q]; }
            *(LAS u32x4*)(PS + (tid >> 3) * JST + (tid & 7) * 8) = rp;
            if (tid < 256) { const int j = tid >> 2, ch = tid & 3; LAS bf16_t* vd = VT + (ch * 8) * JST + j;
                vd[0 * JST] = (bf16_t)(rv.x & 0xffffu); vd[1 * JST] = (bf16_t)(rv.x >> 16); vd[2 * JST] = (bf16_t)(rv.y & 0xffffu); vd[3 * JST] = (bf16_t)(rv.y >> 16);
                vd[4 * JST] = (bf16_t)(rv.z & 0xffffu); vd[5 * JST] = (bf16_t)(rv.z >> 16); vd[6 * JST] = (bf16_t)(rv.w & 0xffffu); vd[7 * JST] = (bf16_t)(rv.w >> 16); }
            if (tid < 128) DEC[tid] = rd;
            if (c + 1 < 64) GLA_LOAD(c + 1);
            __syncthreads();
            f32x4 oacc = (f32x4){0.f, 0.f, 0.f, 0.f};
#pragma unroll
            for (int ks = 0; ks < 4; ++ks) { const bf16x8 af = *(const LAS bf16x8*)(QD + (mi * 16 + l15) * QST + ks * 32 + 8 * g4);
                const bf16x8 sfr = *(const LAS bf16x8*)(STR + (half * 16 + l15) * QST + ks * 32 + 8 * g4); oacc = mfma16(af, sfr, oacc); }
#pragma unroll
            for (int ks = 0; ks < 2; ++ks) { const bf16x8 af = *(const LAS bf16x8*)(PS + (mi * 16 + l15) * JST + ks * 32 + 8 * g4);
                const bf16x8 bfr = *(const LAS bf16x8*)(VT + (half * 16 + l15) * JST + ks * 32 + 8 * g4); oacc = mfma16(af, bfr, oacc); }
#pragma unroll
            for (int r = 0; r < 4; ++r) { const int i = mi * 16 + g4 * 4 + r;
                ost[oitem * 131072 + (size_t)(c * 64 + i) * 32 + half * 16 + l15] = f2bf(oacc[r]); }
            { const float dc = DEC[wave * 16 + l15];
#pragma unroll
              for (int vt = 0; vt < 2; ++vt) { st[vt] = st[vt] * dc;
#pragma unroll
                for (int ks = 0; ks < 2; ++ks) { const bf16x8 af = *(const LAS bf16x8*)(VT + (vt * 16 + l15) * JST + ks * 32 + 8 * g4);
                    const bf16x8 bfr = *(const LAS bf16x8*)(KST + (wave * 16 + l15) * JST + ks * 32 + 8 * g4); st[vt] = mfma16(af, bfr, st[vt]); }
#pragma unroll
                for (int r = 0; r < 4; ++r) STW[(vt * 16 + g4 * 4 + r) * QST + wave * 16 + l15] = f2bf(st[vt][r]); } }
        }
#undef GLA_LOAD
    }
}
__device__ __forceinline__ void gla_post(GAS bf16_t* proj, const GAS bf16_t* ost, const GAS float* o_norm, const int tid) {
    const int lane = tid & 63, wave = tid >> 6;
    const int gw = blockIdx.x * 8 + wave, NGW = gridDim.x * 8;
    float gn[16];
#pragma unroll
    for (int e = 0; e < 16; ++e) gn[e] = o_norm[(lane & 15) * 16 + e];
    for (int r = gw; r < MROWS; r += NGW) {
        const int b = r >> 12, t = r & 4095, h = lane >> 4, p = lane & 15;
        const GAS u32x4* op = (const GAS u32x4*)(ost + (size_t)((b * 4 + h) * 8 + (p >> 1)) * 131072 + (size_t)t * 32 + (p & 1) * 16);
        GAS u32x4* dp = (GAS u32x4*)(proj + (size_t)r * 3328 + 1024 + lane * 16); const GAS u32x4* rp = (const GAS u32x4*)(proj + (size_t)r * 3328 + 2048 + lane * 16);
        const u32x4 ov0 = op[0], ov1 = op[1];
        float hs = 0.f;
#pragma unroll
        for (int e = 0; e < 4; ++e) { const float a0 = bflo(ov0[e]), a1 = bfhi(ov0[e]), c0 = bflo(ov1[e]), c1 = bfhi(ov1[e]); hs += (a0 * a0 + a1 * a1) + (c0 * c0 + c1 * c1); }
        hs += __shfl_xor(hs, 1); hs += __shfl_xor(hs, 2); hs += __shfl_xor(hs, 4); hs += __shfl_xor(hs, 8);
        const float rs = __builtin_amdgcn_rsqf(hs * (1.0f / 256.0f) + pg8::RMS_EPS);
#pragma unroll
        for (int q = 0; q < 2; ++q) { const u32x4 ov = q ? ov1 : ov0, rv = rp[q]; u32x4 w;
#pragma unroll
            for (int e = 0; e < 4; ++e) { const float o0 = bflo(ov[e]), o1 = bfhi(ov[e]), r0 = bflo(rv[e]), r1 = bfhi(rv[e]);
                w[e] = cvt_pk_bf16(o0 * rs * gn[q * 8 + 2 * e] * pg8::silu_f(r0), o1 * rs * gn[q * 8 + 2 * e + 1] * pg8::silu_f(r1)); }
            dp[q] = w; }
    }
}

__device__ __forceinline__ void sgu_spatial(LAS unsigned char* lds, GAS bf16_t* uv  , const GAS float* lnstat  , int row0,
                                            const GAS float* ln_g, const GAS float* ln_b, const GAS float* w_s, const GAS float* b_s, const int tid) {
    const int lane = tid & 63, wave = tid >> 6, l15 = lane & 15, g4 = lane >> 4;
    constexpr int ST = 136;
    LAS bf16_t* WS = (LAS bf16_t*)lds;
    LAS bf16_t* VT = WS + 128 * ST;
    LAS float* STAT = (LAS float*)(VT + 384 * ST);
    int gcur = -1;
    for (int item = blockIdx.x; item < 1024; item += gridDim.x) {
        const int cc = item >> 3, g = item & 7;
        __syncthreads();
        if (g != gcur) { gcur = g;
            for (int idx = tid; idx < 128 * 32; idx += 512) { const int i = idx >> 5, j4 = (idx & 31) * 4;
                const f32x4 w = *(const GAS f32x4*)(w_s + (size_t)g * 16384 + i * 128 + j4);
                u32x2 o; o.x = cvt_pk_bf16(j4 <= i ? w[0] : 0.f, j4 + 1 <= i ? w[1] : 0.f); o.y = cvt_pk_bf16(j4 + 2 <= i ? w[2] : 0.f, j4 + 3 <= i ? w[3] : 0.f);
                *(LAS u32x2*)(WS + i * ST + j4) = o; } }
        if (tid < 128) { const GAS f32x4* lp = (const GAS f32x4*)(lnstat + 24 * (size_t)(row0 + cc * 128 + tid)); float s1 = 0.f, s2 = 0.f;
#pragma unroll
            for (int q = 0; q < 6; ++q) { const f32x4 v = lp[q]; s1 += v[0] + v[2]; s2 += v[1] + v[3]; }
            const float mean = s1 * (1.0f / 3072.0f), var = s2 * (1.0f / 3072.0f) - mean * mean;
            STAT[2 * tid] = mean; STAT[2 * tid + 1] = __builtin_amdgcn_rsqf(fmaxf(var, 0.f) + pg8::RMS_EPS); }
        __syncthreads();
        for (int idx = tid; idx < 32 * 48; idx += 512) { const int jg = idx / 48, ch = idx % 48, j0 = jg * 4;
            const f32x4 ga = *(const GAS f32x4*)(ln_g + g * 384 + ch * 8), gb = *(const GAS f32x4*)(ln_g + g * 384 + ch * 8 + 4);
            const f32x4 ba = *(const GAS f32x4*)(ln_b + g * 384 + ch * 8), bb = *(const GAS f32x4*)(ln_b + g * 384 + ch * 8 + 4);
            float vn[4][8];
#pragma unroll
            for (int q = 0; q < 4; ++q) { const int tl = cc * 128 + j0 + q;
                const u32x4 raw = *(const GAS u32x4*)(uv + (size_t)tl * 6144 + 3072 + g * 384 + ch * 8);
                const float mean = STAT[2 * (j0 + q)], rs = STAT[2 * (j0 + q) + 1];
                vn[q][0] = (bflo(raw.x) - mean) * rs * ga[0] + ba[0]; vn[q][1] = (bfhi(raw.x) - mean) * rs * ga[1] + ba[1];
                vn[q][2] = (bflo(raw.y) - mean) * rs * ga[2] + ba[2]; vn[q][3] = (bfhi(raw.y) - mean) * rs * ga[3] + ba[3];
                vn[q][4] = (bflo(raw.z) - mean) * rs * gb[0] + bb[0]; vn[q][5] = (bfhi(raw.z) - mean) * rs * gb[1] + bb[1];
                vn[q][6] = (bflo(raw.w) - mean) * rs * gb[2] + bb[2]; vn[q][7] = (bfhi(raw.w) - mean) * rs * gb[3] + bb[3]; }
#pragma unroll
            for (int e = 0; e < 8; ++e) { u32x2 o; o.x = cvt_pk_bf16(vn[0][e], vn[1][e]); o.y = cvt_pk_bf16(vn[2][e], vn[3][e]); *(LAS u32x2*)(VT + (ch * 8 + e) * ST + (((j0 >> 2) ^ ((ch & 7) << 1)) << 2)) = o; } }
        __syncthreads();
        f32x4 acc[8][3];
#pragma unroll
        for (int mt = 0; mt < 8; ++mt)
#pragma unroll
            for (int nt = 0; nt < 3; ++nt) acc[mt][nt] = (f32x4){0.f, 0.f, 0.f, 0.f};
#pragma unroll
        for (int ks = 0; ks < 4; ++ks) {
            bf16x8 bfr[3];
#pragma unroll
            for (int nt = 0; nt < 3; ++nt) { const int row = wave * 48 + nt * 16 + l15; bfr[nt] = *(const LAS bf16x8*)(VT + row * ST + (((ks * 4 + g4) ^ ((row >> 3) & 7)) << 3)); }
#pragma unroll
            for (int mt = 0; mt < 8; ++mt) { if (ks * 32 <= mt * 16 + 15) {
                const bf16x8 af = *(const LAS bf16x8*)(WS + (mt * 16 + l15) * ST + ks * 32 + 8 * g4);
#pragma unroll
                for (int nt = 0; nt < 3; ++nt) acc[mt][nt] = mfma16(bfr[nt], af, acc[mt][nt]); } }
        }
        u32x2 uuv[8][3]; float bsv[8];
#pragma unroll
        for (int mt = 0; mt < 8; ++mt) { const int i = mt * 16 + l15; bsv[mt] = b_s[g * 128 + i];
            const GAS bf16_t* up = uv + (size_t)(cc * 128 + i) * 6144 + g * 384 + wave * 48 + g4 * 4;
#pragma unroll
            for (int nt = 0; nt < 3; ++nt) uuv[mt][nt] = *(const GAS u32x2*)(up + nt * 16); }
#pragma unroll
        for (int mt = 0; mt < 8; ++mt) { const int i = mt * 16 + l15; const float bs = bsv[mt];
            GAS bf16_t* up = uv + (size_t)(cc * 128 + i) * 6144 + g * 384 + wave * 48 + g4 * 4;
#pragma unroll
            for (int nt = 0; nt < 3; ++nt) { const u32x2 uu = uuv[mt][nt]; u32x2 o;
                o.x = cvt_pk_bf16(bflo(uu.x) * (acc[mt][nt][0] + bs), bfhi(uu.x) * (acc[mt][nt][1] + bs)); o.y = cvt_pk_bf16(bflo(uu.y) * (acc[mt][nt][2] + bs), bfhi(uu.y) * (acc[mt][nt][3] + bs));
                *(GAS u32x2*)(up + nt * 16) = o; } }
    }
}

__device__ __forceinline__ u32x4 rope8(const GAS bf16_t* p16  , const GAS float* cs  , bool second) {
    const u32x4 x1 = *(const GAS u32x4*)p16, x2 = *(const GAS u32x4*)(p16 + 8);
    const f32x4 c0 = *(const GAS f32x4*)cs, c1 = *(const GAS f32x4*)(cs + 4), s0 = *(const GAS f32x4*)(cs + 8), s1 = *(const GAS f32x4*)(cs + 12);
    float o[8];
#pragma unroll
    for (int e = 0; e < 4; ++e) {
        const float a0 = bflo(x1[e]), a1 = bfhi(x1[e]), b0 = bflo(x2[e]), b1 = bfhi(x2[e]);
        const float cc0 = (e < 2) ? c0[2 * e] : c1[2 * e - 4], cc1 = (e < 2) ? c0[2 * e + 1] : c1[2 * e - 3];
        const float ss0 = (e < 2) ? s0[2 * e] : s1[2 * e - 4], ss1 = (e < 2) ? s0[2 * e + 1] : s1[2 * e - 3];
        o[2 * e] = second ? (b0 * cc0 + a0 * ss0) : (a0 * cc0 - b0 * ss0);
        o[2 * e + 1] = second ? (b1 * cc1 + a1 * ss1) : (a1 * cc1 - b1 * ss1);
    }
    u32x4 w; w.x = cvt_pk_bf16(o[0], o[1]); w.y = cvt_pk_bf16(o[2], o[3]); w.z = cvt_pk_bf16(o[4], o[5]); w.w = cvt_pk_bf16(o[6], o[7]); return w;
}
__device__ __forceinline__ void swa_attn(LAS unsigned char* lds, const GAS bf16_t* qkv  , GAS bf16_t* ao  , const GAS float* rope, const GAS float* sinks, const int tid) {
    const int lane = tid & 63, wave = tid >> 6, l15 = lane & 15, g4 = lane >> 4;
    constexpr int KSTR = 72, VSTR = 264, PSTR = 168;
    LAS bf16_t* Ks = (LAS bf16_t*)lds;
    LAS bf16_t* Vt = Ks + 256 * KSTR;
    LAS bf16_t* Ps = Vt + 64 * VSTR + wave * 16 * PSTR;
    for (int item = blockIdx.x; item < 512; item += gridDim.x) {
        const int kvh = item & 1, n = (item >> 1) & 31, b = item >> 6;
        const int tok0 = b * SEQL + n * 128;
        __syncthreads();
        for (int idx = tid; idx < 256 * 8; idx += 512) {
            const int jb = idx >> 3, ch = idx & 7; const int tok = tok0 - 128 + jb;
            u32x4 kq = (u32x4){0u, 0u, 0u, 0u}, vq = (u32x4){0u, 0u, 0u, 0u};
            if (n > 0 || jb >= 128) {
                const GAS bf16_t* krow = qkv + (size_t)tok * 1280 + 1024 + kvh * 64;
                vq = *(const GAS u32x4*)(qkv + (size_t)tok * 1280 + 1152 + kvh * 64 + ch * 8);
                if (ch < 2) kq = rope8(krow, rope + (size_t)tok * 16, ch == 1); else kq = *(const GAS u32x4*)(krow + ch * 8);
            }
            *(LAS u32x4*)(Ks + jb * KSTR + ch * 8) = kq;
            LAS bf16_t* vd = Vt + (ch * 8) * VSTR + jb;
            vd[0 * VSTR] = (bf16_t)(vq.x & 0xffffu); vd[1 * VSTR] = (bf16_t)(vq.x >> 16); vd[2 * VSTR] = (bf16_t)(vq.y & 0xffffu); vd[3 * VSTR] = (bf16_t)(vq.y >> 16);
            vd[4 * VSTR] = (bf16_t)(vq.z & 0xffffu); vd[5 * VSTR] = (bf16_t)(vq.z >> 16); vd[6 * VSTR] = (bf16_t)(vq.w & 0xffffu); vd[7 * VSTR] = (bf16_t)(vq.w >> 16);
        }
        __syncthreads();
        const int hq = kvh * 8 + wave; const float sink = sinks[hq];
        for (int i = 0; i < 8; ++i) {
            const int qtok = tok0 + 16 * i + l15; const GAS bf16_t* qp = qkv + (size_t)qtok * 1280 + hq * 64;
            bf16x8 qa[2];
            qa[1] = *(const GAS bf16x8*)(qp + 32 + 8 * g4);
            { u32x4 q0; if (g4 < 2) q0 = rope8(qp, rope + (size_t)qtok * 16, g4 == 1); else q0 = *(const GAS u32x4*)(qp + 8 * g4); qa[0] = __builtin_bit_cast(bf16x8, q0); }
            const int t0 = (i < 6) ? i : 6;
            f32x4 s[10];
#pragma unroll
            for (int nt = 0; nt < 10; ++nt) { s[nt] = (f32x4){0.f, 0.f, 0.f, 0.f};
#pragma unroll
                for (int ks = 0; ks < 2; ++ks) { const bf16x8 kb = *(const LAS bf16x8*)(Ks + ((t0 + nt) * 16 + l15) * KSTR + ks * 32 + 8 * g4); s[nt] = mfma16(qa[ks], kb, s[nt]); } }
            float inv[4];
#pragma unroll
            for (int r = 0; r < 4; ++r) {
                const int ql = 16 * i + g4 * 4 + r; float mx = sink;
#pragma unroll
                for (int nt = 0; nt < 10; ++nt) { const int jb = (t0 + nt) * 16 + l15; const bool ok = (jb > ql) && (jb <= ql + 128) && (n > 0 || jb >= 128);
                    const float v = ok ? s[nt][r] * 0.125f : -INFINITY; s[nt][r] = v; mx = fmaxf(mx, v); }
                mx = fmaxf(mx, __shfl_xor(mx, 1)); mx = fmaxf(mx, __shfl_xor(mx, 2)); mx = fmaxf(mx, __shfl_xor(mx, 4)); mx = fmaxf(mx, __shfl_xor(mx, 8));
                float sum = 0.f;
#pragma unroll
                for (int nt = 0; nt < 10; ++nt) { const float p = __expf(s[nt][r] - mx); sum += p; Ps[(g4 * 4 + r) * PSTR + nt * 16 + l15] = f2bf(p); }
                sum += __shfl_xor(sum, 1); sum += __shfl_xor(sum, 2); sum += __shfl_xor(sum, 4); sum += __shfl_xor(sum, 8);
                inv[r] = 1.0f / (sum + __expf(sink - mx));
            }
            asm volatile("s_waitcnt lgkmcnt(0)" ::: "memory");
            f32x4 o[4] = {(f32x4){0.f, 0.f, 0.f, 0.f}, (f32x4){0.f, 0.f, 0.f, 0.f}, (f32x4){0.f, 0.f, 0.f, 0.f}, (f32x4){0.f, 0.f, 0.f, 0.f}};
#pragma unroll
            for (int ks = 0; ks < 5; ++ks) { const bf16x8 pa = *(const LAS bf16x8*)(Ps + l15 * PSTR + ks * 32 + 8 * g4);
#pragma unroll
                for (int dt = 0; dt < 4; ++dt) { const bf16x8 vb = *(const LAS bf16x8*)(Vt + (dt * 16 + l15) * VSTR + t0 * 16 + ks * 32 + 8 * g4); o[dt] = mfma16(pa, vb, o[dt]); } }
            asm volatile("s_waitcnt lgkmcnt(0)" ::: "memory");
#pragma unroll
            for (int r = 0; r < 4; ++r) { GAS bf16_t* op = ao + (size_t)(tok0 + 16 * i + g4 * 4 + r) * 1024 + hq * 64 + l15;
#pragma unroll
                for (int dt = 0; dt < 4; ++dt) op[dt * 16] = f2bf(o[dt][r] * inv[r]); }
        }
    }
}

__device__ __forceinline__ void final_norm(const GAS bf16_t* xb, GAS float* out, const GAS float* ssq, const GAS float* gain, const int tid) {
    const int lane = tid & 63, wave = tid >> 6, gw = blockIdx.x * 8 + wave, NGW = gridDim.x * 8;
    f32x4 gv[4];
#pragma unroll
    for (int j = 0; j < 4; ++j) gv[j] = *((const GAS f32x4*)(gain + lane * 16) + j);
    for (int r = gw; r < MROWS; r += NGW) { const float rs = __builtin_amdgcn_rsqf(pg8::ssq4(ssq, r) * (1.0f / 1024.0f) + pg8::RMS_EPS);
        const GAS u32x4* xp = (const GAS u32x4*)(xb + (size_t)r * 1024 + lane * 16); GAS f32x4* op = (GAS f32x4*)(out + (size_t)r * 1024 + lane * 16);
        const u32x4 a = xp[0], b = xp[1];
        op[0] = (f32x4){bflo(a.x), bfhi(a.x), bflo(a.y), bfhi(a.y)} * rs * gv[0]; op[1] = (f32x4){bflo(a.z), bfhi(a.z), bflo(a.w), bfhi(a.w)} * rs * gv[1];
        op[2] = (f32x4){bflo(b.x), bfhi(b.x), bflo(b.y), bfhi(b.y)} * rs * gv[2]; op[3] = (f32x4){bflo(b.z), bfhi(b.z), bflo(b.w), bfhi(b.w)} * rs * gv[3]; }
}

#define XB_TMO      128
#define XB_XCNT(j)  (256  + 64 * (j))
#define XB_XSUB(j)  (1280 + 64 * (j))
#define XB_XGEN(j)  (2304 + 64 * (j))
#define XB_TOP      3328
#define XB_TOPGEN   3392
#define XCD_BAR_WORDS 3456
#define XB_SPIN_CAP (1u << 18)

__device__ __forceinline__ unsigned xb_ld(unsigned* p)              { return __hip_atomic_load(p, __ATOMIC_RELAXED, __HIP_MEMORY_SCOPE_AGENT); }
__device__ __forceinline__ unsigned xb_add(unsigned* p, unsigned v) { return __hip_atomic_fetch_add(p, v, __ATOMIC_RELAXED, __HIP_MEMORY_SCOPE_AGENT); }
__device__ __forceinline__ unsigned xb_xcc_id() { return (unsigned)__builtin_amdgcn_s_getreg((3 << 11) | 20) & 0xFu; }
#define XB_SPIN(cond, bar) do { unsigned _sp = 0; while (cond) { __builtin_amdgcn_s_sleep(1); \
    if ((++_sp & 255u) == 0u) { if (xb_ld(&(bar)[XB_TMO])) break; if (_sp > XB_SPIN_CAP) { atomicAdd(&(bar)[XB_TMO], 1u); break; } } } } while (0)

struct XcdBarrier {
    unsigned* bar; unsigned x;
    volatile LAS unsigned* st;
};

__device__ __forceinline__ XcdBarrier xcd_barrier_post(unsigned* bar, volatile LAS unsigned* st) {
    XcdBarrier b; b.bar = bar; b.x = xb_xcc_id(); b.st = st;
    if (threadIdx.x == 0) (void)xb_add(&bar[XB_XCNT(b.x)], 1u);
    return b;
}
__device__ __forceinline__ void xcd_barrier_complete(unsigned* bar, unsigned x, unsigned& nloc, unsigned& nx) {
    const unsigned G = gridDim.x * gridDim.y * gridDim.z;
    unsigned sum, cnt, mine, sp = 0u;
    for (;;) {
        sum = 0u; cnt = 0u; mine = 0u;
#pragma unroll
        for (unsigned j = 0; j < 16; ++j) { const unsigned c = xb_ld(&bar[XB_XCNT(j)]); sum += c; cnt += (c > 0u) ? 1u : 0u; mine = (j == x) ? c : mine; }
        if (sum == G) break;
        __builtin_amdgcn_s_sleep(1);
        if ((++sp & 255u) == 0u) { if (xb_ld(&bar[XB_TMO])) break; if (sp > XB_SPIN_CAP) { atomicAdd(&bar[XB_TMO], 1u); break; } }
    }
    nloc = mine > 0u ? mine : 1u; nx = cnt > 0u ? cnt : 1u;
}

__device__ __forceinline__ void xcd_barrier(const XcdBarrier& b) {
    asm volatile("s_waitcnt vmcnt(0)" ::: "memory");
    __syncthreads();
    if (threadIdx.x == 0) {
        unsigned* bar = b.bar;
        __builtin_amdgcn_s_waitcnt(0);
        unsigned nloc = b.st[0], nx = b.st[1];
        if (nloc == 0u) { xcd_barrier_complete(bar, b.x, nloc, nx); b.st[0] = nloc; b.st[1] = nx; }
        const unsigned old = xb_add(&bar[XB_XSUB(b.x)], 1u);
        const unsigned gen = old / nloc;
        if (old + 1u == (gen + 1u) * nloc) {
            __builtin_amdgcn_fence(__ATOMIC_RELEASE, "agent");
            asm volatile("s_waitcnt vmcnt(0)" ::: "memory");
            const unsigned og = xb_add(&bar[XB_TOP], 1u);
            const unsigned tg = og / nx;
            if (og + 1u == (tg + 1u) * nx) xb_add(&bar[XB_TOPGEN], 1u);
            else XB_SPIN(xb_ld(&bar[XB_TOPGEN]) == tg, bar);
            __builtin_amdgcn_fence(__ATOMIC_ACQUIRE, "agent");
            xb_add(&bar[XB_XGEN(b.x)], 1u);
            asm volatile("s_waitcnt vmcnt(0)" ::: "memory");
        } else {
            XB_SPIN(xb_ld(&bar[XB_XGEN(b.x)]) == gen, bar);
            __builtin_amdgcn_fence(__ATOMIC_ACQUIRE, "agent");
            asm volatile("s_waitcnt vmcnt(0)" ::: "memory");
        }
    }
    __syncthreads();
}

#define OPW(k, l, s, h) ((unsigned short)((k) | ((l) << 4) | ((s) << 8) | ((h) << 9)))
constexpr int NOPS = 37;
__constant__ unsigned short OPS[NOPS] = {
    OPW(0,0,0,0),
    OPW(1,0,0,0), OPW(2,0,0,0), OPW(3,0,0,0), OPW(12,0,0,0), OPW(5,0,0,0), OPW(6,0,0,0), OPW(4,0,0,0), OPW(1,0,1,0), OPW(2,0,1,0),
    OPW(1,1,0,0), OPW(2,1,0,0), OPW(3,1,0,0), OPW(7,1,0,0), OPW(4,1,0,0), OPW(3,1,0,1), OPW(7,1,0,1), OPW(4,1,0,1), OPW(1,1,1,0), OPW(2,1,1,0),
    OPW(1,2,0,0), OPW(2,2,0,0), OPW(3,2,0,0), OPW(8,2,0,0), OPW(4,2,0,0), OPW(1,2,1,0), OPW(2,2,1,0),
    OPW(1,3,0,0), OPW(2,3,0,0), OPW(3,3,0,0), OPW(12,3,0,0), OPW(5,3,0,0), OPW(6,3,0,0), OPW(4,3,0,0), OPW(1,3,1,0), OPW(2,3,1,0),
    OPW(9,0,0,0) };

__global__ void __launch_bounds__(512, 2) mega_fwd(Args a) {
    extern __shared__ __attribute__((aligned(16))) unsigned char lds_raw[];
    LAS unsigned char* lds = (LAS unsigned char*)lds_raw;
    cg::grid_group grid = cg::this_grid();
    const int G = gridDim.x;
    volatile LAS unsigned* barst = (volatile LAS unsigned*)(lds + LDS_BYTES - 16);
    if (threadIdx.x < 4) barst[threadIdx.x] = 0u;
    __syncthreads();
    (void)xcd_barrier_post((unsigned*)(a.ws + WS_BAR), barst);
    for (int op = 0; op < NOPS; ++op) {
        int tid; asm volatile("v_mov_b32 %0, %1" : "=v"(tid) : "v"((int)threadIdx.x));
        KPTR kp = (KPTR)__builtin_amdgcn_kernarg_segment_ptr(); asm volatile("" : "+s"(kp));
        GAS unsigned char* ws = (GAS unsigned char*)kp[53]; GAS float* outp = (GAS float*)kp[52];
        GAS bf16_t* xb = (GAS bf16_t*)(ws + WS_XB); GAS bf16_t* temp = (GAS bf16_t*)(ws + WS_TEMP);
        GAS float* ssq = (GAS float*)(ws + WS_SSQ); GAS float* lnstat = (GAS float*)(ws + WS_LNSTAT);
        const unsigned w = OPS[op]; const int kind = w & 15, L = (w >> 4) & 3, sub = (w >> 8) & 1, hf = (w >> 9) & 1;
        const int base = layer_base(L);
        if (kind == 0) { p0_prologue(kp, ws, lds, tid); }
        else if (kind == 1) {
            pg8::Gemm g{xb, (const GAS bf16_t*)(ws + WS_FFN + (size_t)(L * 2 + sub) * SZ_FFN), MROWS, 5632, 1024, 1024};
            pg8::StaticOrder S; S.init(MROWS, 5632, G, (int)blockIdx.x);
            pg8::EpiSwiGLU E{temp, DFF, ssq + (size_t)(3 * L + 2 * sub) * 4 * MROWS};
            pg8::gemm_phase<pg8::EpiSwiGLU, pg8::StaticOrder, true, true>(lds, g, S, E, tid);
        } else if (kind == 2) {
            pg8::Gemm g{temp, (const GAS bf16_t*)(ws + WS_FFN + (size_t)(L * 2 + sub) * SZ_FFN + SZ_FFN_IN), MROWS, 1024, 2816, 2816};
            pg8::StaticOrder S; S.init(MROWS, 1024, G, (int)blockIdx.x);
            pg8::EpiRes E{xb, ssq + (size_t)(3 * L + 2 * sub + 1) * 4 * MROWS, nullptr, 0.5f, 0, (LAS float*)(lds + 131072), tid};
            pg8::gemm_phase<pg8::EpiRes, pg8::StaticOrder, true, true>(lds, g, S, E, tid);
        } else if (kind == 3) {
            const GAS bf16_t* Bt = (const GAS bf16_t*)mixer_w(ws, L);
            const int Mh = (L == 1) ? MROWS / 2 : MROWS, N = (L == 1) ? 6144 : (L == 2 ? 1280 : 3328), row0 = hf * (MROWS / 2);
            pg8::Gemm g{xb + (size_t)row0 * 1024, Bt, Mh, N, 1024, 1024};
            pg8::StaticOrder S; S.init(Mh, N, G, (int)blockIdx.x);
            pg8::EpiPlain E{temp, N, ssq + (size_t)(3 * L + 1) * 4 * MROWS, (L == 2) ? ARGP(32) : nullptr, (L == 1) ? 1 : 0, (L == 1) ? lnstat : nullptr, 12, row0, (LAS float*)(lds + 131072), tid};
            pg8::gemm_phase<pg8::EpiPlain, pg8::StaticOrder, true, true>(lds, g, S, E, tid);
        } else if (kind == 4) {
            const GAS bf16_t* Bt = (const GAS bf16_t*)(mixer_w(ws, L) + mixer_in_sz(L));
            const int Mh = (L == 1) ? MROWS / 2 : MROWS, K = (L == 1) ? 3072 : 1024, row0 = hf * (MROWS / 2);
            const GAS bf16_t* A = (L == 1) ? temp : (L == 2 ? temp + (size_t)MROWS * 1280 : temp + 1024);
            const int lda = (L == 1) ? 6144 : (L == 2 ? 1024 : 3328);
            pg8::Gemm g{A, Bt, Mh, 1024, K, lda};
            pg8::StaticOrder S; S.init(Mh, 1024, G, (int)blockIdx.x);
            pg8::EpiRes E{xb, ssq + (size_t)(3 * L + 2) * 4 * MROWS, (L == 2) ? ARGP(35) : nullptr, 1.0f, row0, (LAS float*)(lds + 131072), tid};
            pg8::gemm_phase<pg8::EpiRes, pg8::StaticOrder, true, true>(lds, g, S, E, tid);
        } else if (kind == 5) { gla_core(lds, temp, (const GAS bf16_t*)(ws + WS_KST), (const GAS float*)(ws + WS_DEC), (const GAS bf16_t*)(ws + WS_PBUF), (GAS bf16_t*)outp, tid); }
        else if (kind == 12) { gla_pre(lds, temp, (GAS bf16_t*)(ws + WS_KST), (GAS float*)(ws + WS_DEC), (GAS bf16_t*)(ws + WS_PBUF), ARGP(base + 5), ARGP(base + 6), tid); }
        else if (kind == 6) { gla_post(temp, (const GAS bf16_t*)outp, ARGP(base + 7), tid); }
        else if (kind == 7) { sgu_spatial(lds, temp, lnstat, hf * (MROWS / 2), ARGP(19), ARGP(20), ARGP(21), ARGP(22), tid); }
        else if (kind == 8) { swa_attn(lds, temp, temp + (size_t)MROWS * 1280, (const GAS float*)(ws + WS_ROPE), ARGP(33), tid); }
        else { final_norm(xb, outp, ssq + (size_t)12 * 4 * MROWS, ARGP(51), tid); }
        if (G == 0x7fffffff) {
            grid.sync();
        } else if (op + 1 < NOPS) { XcdBarrier xbar; xbar.bar = (unsigned*)((unsigned char*)kp[53] + WS_BAR); xbar.x = xb_xcc_id(); xbar.st = (volatile LAS unsigned*)(lds + LDS_BYTES - 16); xcd_barrier(xbar); }
    }
}

extern "C" void kernel_launch(void* const* d_in, const int* in_sizes, int n_in, void* d_out, int out_size, void* d_ws, size_t ws_size, hipStream_t stream) {
    static int grid = 0;
    if (grid == 0) {
        if (n_in != 52 || out_size != MROWS * DM || ws_size < WS_END2) { fprintf(stderr, "kernel_launch: unexpected shapes: n_in %d out %d ws %zu (need %zu)\n", n_in, out_size, ws_size, (size_t)WS_END2); grid = -1; return; }
        int dev = 0, cus = 0, per_cu = 0;
        hipGetDevice(&dev); hipDeviceGetAttribute(&cus, hipDeviceAttributeMultiprocessorCount, dev);
        if (hipFuncSetAttribute((const void*)mega_fwd, hipFuncAttributeMaxDynamicSharedMemorySize, LDS_BYTES) != hipSuccess) { fprintf(stderr, "kernel_launch: hipFuncSetAttribute failed\n"); grid = -1; return; }
        if (hipOccupancyMaxActiveBlocksPerMultiprocessor(&per_cu, (const void*)mega_fwd, 512, LDS_BYTES) != hipSuccess || per_cu < 1) { fprintf(stderr, "kernel_launch: occupancy query says %d\n", per_cu); per_cu = 1; }
        (void)hipGetLastError();
        grid = cus;
    }
    if (grid < 0) return;
    if (hipMemsetAsync((char*)d_ws + WS_BAR, 0, WS_BAR_BYTES, stream) != hipSuccess) { fprintf(stderr, "kernel_launch: memset of barrier words failed\n"); return; }
    Args a{};
    for (int i = 0; i < 52; ++i) a.in[i] = (const float*)d_in[i];
    a.out = (float*)d_out; a.ws = (unsigned char*)d_ws;
    void* args[] = {&a};
    hipError_t e = hipLaunchCooperativeKernel((const void*)mega_fwd, dim3(grid), dim3(512), args, LDS_BYTES, stream);
    if (e != hipSuccess) fprintf(stderr, "kernel_launch: cooperative launch failed: %s (grid %d)\n", hipGetErrorString(e), grid);
}
```

```cpp
#include <hip/hip_runtime.h>
#include <hip/hip_cooperative_groups.h>
#include <cstdio>
#include <cstdint>
#include <cmath>
namespace cg = cooperative_groups;
namespace pg8 {
#define PG8_LAS __attribute__((address_space(3)))
#define GAS __attribute__((address_space(1)))
typedef unsigned short bf16_t;
typedef short bf16x8 __attribute__((ext_vector_type(8)));
typedef float f32x4 __attribute__((ext_vector_type(4)));
typedef unsigned u32x4 __attribute__((ext_vector_type(4)));
constexpr int BM = 256, BK = 64, HALF = 128, HTB = HALF * BK * 2  , STAGE_BYTES = 8 * HTB, NXCD = 8, WGM = 8;

__host__ __device__ __forceinline__ int lds_byte(int r, int c) { const int st = (r >> 4) * 2 + (c >> 5), rr = r & 15, cc = c & 31, ob = rr * 64 + cc * 2; return st * 1024 + (ob ^ (((ob >> 9) & 1) << 5)); }
__host__ __device__ __forceinline__ void stage_rc(int b, int& R, int& C) { const int st = b / 1024, sb = b % 1024, swz = sb ^ (((sb >> 9) & 1) << 5); R = (st >> 1) * 16 + swz / 64; C = (st & 1) * 32 + (swz % 64) / 2; }
__host__ __device__ __forceinline__ int perm32(int rho) { const int n = rho >> 4, i = rho & 15; return 8 * (i >> 2) + 4 * n + (i & 3); }

struct Unit { int pm, pn; };
struct Gemm { const GAS bf16_t* A; const GAS bf16_t* Bt; int M, N, K, lda; };

struct StaticOrder {
    int nM, nN, nwg, G, c;
    __host__ __device__ void init(int M, int N, int G_, int c_) { nM = M / BM; nN = N / BM; nwg = nM * nN; G = G_; c = c_; }
    __host__ __device__ bool next(int i, Unit& u) const {
        const long L = (long)i * G + c; if (L >= nwg) return false;
        int wgid = (int)L; { const int q = nwg / NXCD, r = nwg % NXCD, xcd = wgid % NXCD, off = wgid / NXCD; wgid = (xcd < r ? xcd * (q + 1) : r * (q + 1) + (xcd - r) * q) + off; }
        const int nig = WGM * nN, gid = wgid / nig, fm = gid * WGM, gsz = (nM - fm) < WGM ? (nM - fm) : WGM;
        u.pm = fm + ((wgid % nig) % gsz); u.pn = (wgid % nig) / gsz; return true;
    }
    __device__ __forceinline__ void a_ready(const Unit&) const {}
    __device__ __forceinline__ void done(const Unit&) const {}
};


typedef __bf16 bf16v2_t __attribute__((ext_vector_type(2)));
__device__ __forceinline__ unsigned cvt_pk_bf16(float lo, float hi) { bf16v2_t v; v.x = (__bf16)lo; v.y = (__bf16)hi; return __builtin_bit_cast(unsigned, v); }
typedef float f32x2 __attribute__((ext_vector_type(2)));
__device__ __forceinline__ f32x2 gelu_pk(f32x2 v) {
    const f32x2 av = __builtin_elementwise_abs(v), d = av * 0.2316418882f + 1.0f;
    f32x2 t; t.x = __builtin_amdgcn_rcpf(d.x); t.y = __builtin_amdgcn_rcpf(d.y);
    f32x2 q = t * 0.5307027145f + (-0.7265760135f); q = q * t + 0.7107068705f; q = q * t + (-0.142248368f); q = q * t + 0.127414796f; q = q * t;
    const f32x2 s = (v * v) * (-0.72134752044f);
    f32x2 e; e.x = __builtin_amdgcn_exp2f(s.x); e.y = __builtin_amdgcn_exp2f(s.y);
    const f32x2 m = v * (q * e), r = v - m;
    f32x2 o; o.x = v.x < 0.f ? m.x : r.x; o.y = v.y < 0.f ? m.y : r.y; return o;
}
__device__ __forceinline__ float silu_f(float g) { return g * __builtin_amdgcn_rcpf(1.0f + __expf(-g)); }
constexpr float RMS_EPS = 1e-5f;
constexpr int SSQ_M = 32768;
__device__ __forceinline__ float ssq4(const GAS float* p, int r) { const f32x4 v = *(const GAS f32x4*)(p + 4 * (size_t)r); return (v[0] + v[1]) + (v[2] + v[3]); }

struct EpiSwiGLU {
    static constexpr bool PERM = true, AFTER_DRAIN = false;
    GAS bf16_t* H; int ldh; const GAS float* ssq;
    __device__ __forceinline__ void operator()(const f32x4 (&acc)[2][2][4][2], const Unit& u, int wr, int wc, int fr, int fq) const {
        const int row0 = u.pm * BM + wr * 64 + fr, col0 = u.pn * HALF + wc * 32 + 8 * fq;
        float rsv[2][4];
#pragma unroll
        for (int ai = 0; ai < 2; ++ai)
#pragma unroll
            for (int m = 0; m < 4; ++m) rsv[ai][m] = ssq4(ssq, row0 + ai * HALF + m * 16);
#pragma unroll
        for (int ai = 0; ai < 2; ++ai)
#pragma unroll
            for (int m = 0; m < 4; ++m) {
                const int r = row0 + ai * HALF + m * 16;
                const float rs = __builtin_amdgcn_rsqf(rsv[ai][m] * (1.0f / 1024.0f) + RMS_EPS);
                const float c1 = rs * -1.4426950408889634f, rs2 = rs * rs;
                const f32x4 g0 = acc[ai][0][m][0], g1 = acc[ai][0][m][1];
                f32x4 z0 = g0 * c1, z1 = g1 * c1;
                const f32x4 t0 = (g0 * acc[ai][1][m][0]) * rs2, t1 = (g1 * acc[ai][1][m][1]) * rs2;
#pragma unroll
                for (int k = 0; k < 4; ++k) { z0[k] = __builtin_amdgcn_exp2f(z0[k]); z1[k] = __builtin_amdgcn_exp2f(z1[k]); }
                z0 = z0 + 1.0f; z1 = z1 + 1.0f;
#pragma unroll
                for (int k = 0; k < 4; ++k) { z0[k] = __builtin_amdgcn_rcpf(z0[k]); z1[k] = __builtin_amdgcn_rcpf(z1[k]); }
                const f32x4 h0 = t0 * z0, h1 = t1 * z1;
                float hv[8] = {h0[0], h0[1], h0[2], h0[3], h1[0], h1[1], h1[2], h1[3]};
                u32x4 w; w.x = cvt_pk_bf16(hv[0], hv[1]); w.y = cvt_pk_bf16(hv[2], hv[3]); w.z = cvt_pk_bf16(hv[4], hv[5]); w.w = cvt_pk_bf16(hv[6], hv[7]);
                *(GAS u32x4*)(H + (size_t)r * ldh + col0) = w;
            }
    }
};
__device__ __forceinline__ float bf_lo(unsigned w) { return __builtin_bit_cast(float, w << 16); }
__device__ __forceinline__ float bf_hi(unsigned w) { return __builtin_bit_cast(float, w & 0xffff0000u); }
struct EpiRes {
    static constexpr bool PERM = true, AFTER_DRAIN = false;
    GAS bf16_t* xb; GAS float* ssq_out; const GAS float* bias; float alpha; int row0; PG8_LAS float* red; int tid;
    __device__ __forceinline__ void operator()(const f32x4 (&acc)[2][2][4][2], const Unit& u, int wr, int wc, int fr, int fq) const {
        const int rowb = row0 + u.pm * BM + wr * 64 + fr, col0 = u.pn * BM + wc * 32 + 8 * fq;
        f32x4 bv[2][2];
#pragma unroll
        for (int bj = 0; bj < 2; ++bj)
#pragma unroll
            for (int n = 0; n < 2; ++n) bv[bj][n] = bias ? *(const GAS f32x4*)(bias + col0 + bj * HALF + 4 * n) : (f32x4){0.f, 0.f, 0.f, 0.f};
#pragma unroll
        for (int ai = 0; ai < 2; ++ai) {
            u32x4 xov[4][2];
#pragma unroll
            for (int m = 0; m < 4; ++m)
#pragma unroll
                for (int bj = 0; bj < 2; ++bj) xov[m][bj] = *(const GAS u32x4*)(xb + (size_t)(rowb + ai * HALF + m * 16) * 1024 + col0 + bj * HALF);
#pragma unroll
            for (int m = 0; m < 4; ++m) {
                const int r = rowb + ai * HALF + m * 16; const size_t off = (size_t)r * 1024 + col0; float s = 0.f;
#pragma unroll
                for (int bj = 0; bj < 2; ++bj) {
                    const u32x4 xo = xov[m][bj];
                    const f32x4 o0 = (f32x4){bf_lo(xo.x), bf_hi(xo.x), bf_lo(xo.y), bf_hi(xo.y)}, o1 = (f32x4){bf_lo(xo.z), bf_hi(xo.z), bf_lo(xo.w), bf_hi(xo.w)};
                    const f32x4 v0 = o0 + (acc[ai][bj][m][0] + bv[bj][0]) * alpha, v1 = o1 + (acc[ai][bj][m][1] + bv[bj][1]) * alpha;
                    u32x4 w; w.x = cvt_pk_bf16(v0[0], v0[1]); w.y = cvt_pk_bf16(v0[2], v0[3]); w.z = cvt_pk_bf16(v1[0], v1[1]); w.w = cvt_pk_bf16(v1[2], v1[3]);
                    *(GAS u32x4*)(xb + off + bj * HALF) = w;
                    s += (v0[0] * v0[0] + v0[1] * v0[1]) + (v0[2] * v0[2] + v0[3] * v0[3]) + (v1[0] * v1[0] + v1[1] * v1[1]) + (v1[2] * v1[2] + v1[3] * v1[3]);
                }
                s += __shfl_xor(s, 16); s += __shfl_xor(s, 32);
                if (fq == 0) red[(ai * HALF + wr * 64 + m * 16 + fr) * 4 + wc] = s;
            }
        }
        asm volatile("s_waitcnt lgkmcnt(0)" ::: "memory"); __builtin_amdgcn_s_barrier(); asm volatile("" ::: "memory");
        if (tid < 256) { const f32x4 v = *(const PG8_LAS f32x4*)(red + tid * 4); ssq_out[4 * (size_t)(row0 + u.pm * BM + tid) + u.pn] = (v[0] + v[1]) + (v[2] + v[3]); }
    }
};
struct EpiPlain {
    static constexpr bool PERM = true, AFTER_DRAIN = false;
    GAS bf16_t* O; int ldo; const GAS float* ssq; const GAS float* bias; int act; GAS float* lnstat; int stat_pn0; int row0; PG8_LAS float* red; int tid;
    __device__ __forceinline__ void operator()(const f32x4 (&acc)[2][2][4][2], const Unit& u, int wr, int wc, int fr, int fq) const {
        const int rowl = u.pm * BM + wr * 64 + fr, col0 = u.pn * BM + wc * 32 + 8 * fq;
        const bool dostat = (lnstat != nullptr) && (u.pn >= stat_pn0);
        f32x4 bv[2][2];
#pragma unroll
        for (int bj = 0; bj < 2; ++bj)
#pragma unroll
            for (int n = 0; n < 2; ++n) bv[bj][n] = bias ? *(const GAS f32x4*)(bias + col0 + bj * HALF + 4 * n) : (f32x4){0.f, 0.f, 0.f, 0.f};
        float rsv[2][4];
#pragma unroll
        for (int ai = 0; ai < 2; ++ai)
#pragma unroll
            for (int m = 0; m < 4; ++m) rsv[ai][m] = ssq4(ssq, row0 + rowl + ai * HALF + m * 16);
#pragma unroll
        for (int ai = 0; ai < 2; ++ai)
#pragma unroll
            for (int m = 0; m < 4; ++m) {
                const int rl = rowl + ai * HALF + m * 16, rg = row0 + rl;
                const float rs = __builtin_amdgcn_rsqf(rsv[ai][m] * (1.0f / 1024.0f) + RMS_EPS);
                float s1 = 0.f, s2 = 0.f;
#pragma unroll
                for (int bj = 0; bj < 2; ++bj) {
                    f32x4 v0 = acc[ai][bj][m][0] * rs + bv[bj][0], v1 = acc[ai][bj][m][1] * rs + bv[bj][1];
                    if (act) { const f32x2 a = gelu_pk((f32x2){v0[0], v0[1]}), b = gelu_pk((f32x2){v0[2], v0[3]}), c = gelu_pk((f32x2){v1[0], v1[1]}), d = gelu_pk((f32x2){v1[2], v1[3]});
                        v0 = (f32x4){a.x, a.y, b.x, b.y}; v1 = (f32x4){c.x, c.y, d.x, d.y}; }
                    u32x4 w; w.x = cvt_pk_bf16(v0[0], v0[1]); w.y = cvt_pk_bf16(v0[2], v0[3]); w.z = cvt_pk_bf16(v1[0], v1[1]); w.w = cvt_pk_bf16(v1[2], v1[3]);
                    *(GAS u32x4*)(O + (size_t)rl * ldo + col0 + bj * HALF) = w;
                    s1 += (v0[0] + v0[1]) + (v0[2] + v0[3]) + (v1[0] + v1[1]) + (v1[2] + v1[3]);
                    s2 += (v0[0] * v0[0] + v0[1] * v0[1]) + (v0[2] * v0[2] + v0[3] * v0[3]) + (v1[0] * v1[0] + v1[1] * v1[1]) + (v1[2] * v1[2] + v1[3] * v1[3]);
                }
                if (dostat) {
                    s1 += __shfl_xor(s1, 16); s1 += __shfl_xor(s1, 32); s2 += __shfl_xor(s2, 16); s2 += __shfl_xor(s2, 32);
                    if (fq == 0) { red[(rl - u.pm * BM) * 4 + wc] = s1; red[1024 + (rl - u.pm * BM) * 4 + wc] = s2; }
                }
            }
        if (dostat) {
            asm volatile("s_waitcnt lgkmcnt(0)" ::: "memory"); __builtin_amdgcn_s_barrier(); asm volatile("" ::: "memory");
            if (tid < 256) { const f32x4 a = *(const PG8_LAS f32x4*)(red + tid * 4), b = *(const PG8_LAS f32x4*)(red + 1024 + tid * 4);
                f32x2 o; o.x = (a[0] + a[1]) + (a[2] + a[3]); o.y = (b[0] + b[1]) + (b[2] + b[3]);
                *(GAS f32x2*)(lnstat + 24 * (size_t)(row0 + u.pm * BM + tid) + 2 * (u.pn - stat_pn0)) = o; }
        }
    }
};

template <class Epi, class Sched, bool ALIGN_EPI = false, bool SP2 = false>
__device__ __forceinline__ void gemm_phase(PG8_LAS unsigned char* lds, const Gemm g, const Sched& S, const Epi& E, const int tid) {
    const int wid = __builtin_amdgcn_readfirstlane(tid >> 6), lane = tid & 63, wr = wid >> 2, wc = wid & 3, fr = lane & 15, fq = lane >> 4;
    const int K = g.K, nt = K / BK;
    unsigned voffA[2], voffB[2];
#pragma unroll
    for (int i = 0; i < 2; ++i) { int R, C; stage_rc(tid * 16 + i * 8192, R, C); const int Rb = Epi::PERM ? ((R & ~31) + perm32(R & 31)) : R;
        voffA[i] = (unsigned)(R * g.lda + C) * 2u; voffB[i] = (unsigned)(Rb * K + C) * 2u; }
    const size_t kstep = (size_t)(BK * 2);
    const size_t hstepA = (size_t)HALF * g.lda * 2, hstepB = (size_t)HALF * K * 2;
    const size_t tstepA = 2 * hstepA, tstepB = 2 * hstepB;
    const unsigned ldsw = (unsigned)wid * 1024u;
    const int aoff = lds_byte(wr * 64 + fr, fq * 8), boff = lds_byte(wc * 32 + fr, fq * 8);
#define PG8_SA(b, h) (((b) * 2 + (h)) * HTB)
#define PG8_SB(b, h) ((4 + (b) * 2 + (h)) * HTB)
#define PG8_STAGE(bufoff, gbase, voff) do { _Pragma("unroll") for (int _i = 0; _i < 2; ++_i) \
        __builtin_amdgcn_global_load_lds((const GAS unsigned*)((const GAS char*)(gbase) + (voff)[_i]), (PG8_LAS unsigned*)(lds + (bufoff) + ldsw + _i * 8192), 16, 0, 0); } while (0)
#define PG8_LDA(dst, b, h) do { _Pragma("unroll") for (int m = 0; m < 4; ++m) _Pragma("unroll") for (int k = 0; k < 2; ++k) dst[m][k] = *(const PG8_LAS bf16x8*)(lds + PG8_SA(b, h) + aoff + m * 2048 + k * 1024); } while (0)
#define PG8_LDB(dst, b, h) do { _Pragma("unroll") for (int n = 0; n < 2; ++n) _Pragma("unroll") for (int k = 0; k < 2; ++k) dst[n][k] = *(const PG8_LAS bf16x8*)(lds + PG8_SB(b, h) + boff + n * 2048 + k * 1024); } while (0)
#define PG8_MMA(ai, bj, At, Bt) do { __builtin_amdgcn_s_setprio(1); _Pragma("unroll") for (int m = 0; m < 4; ++m) _Pragma("unroll") for (int n = 0; n < 2; ++n) _Pragma("unroll") for (int k = 0; k < 2; ++k) \
        acc[ai][bj][m][n] = __builtin_amdgcn_mfma_f32_16x16x32_bf16(Bt[n][k], At[m][k], acc[ai][bj][m][n], 0, 0, 0); __builtin_amdgcn_s_setprio(0); } while (0)
#define PG8_WAIT_V(n) asm volatile("s_waitcnt vmcnt(" #n ")" ::: "memory")
#define PG8_WAIT_L(n) asm volatile("s_waitcnt lgkmcnt(" #n ")" ::: "memory")
#define PG8_BAR __builtin_amdgcn_s_barrier()
#define PG8_SCHED __builtin_amdgcn_sched_barrier(0)
    Unit cur, nxt; int ui = 0;
    if (!S.next(0, cur)) return;
    f32x4 acc[2][2][4][2];
#pragma unroll
    for (int a = 0; a < 2; ++a)
#pragma unroll
        for (int b = 0; b < 2; ++b)
#pragma unroll
            for (int m = 0; m < 4; ++m)
#pragma unroll
                for (int n = 0; n < 2; ++n) acc[a][b][m][n] = (f32x4){0.f, 0.f, 0.f, 0.f};
    bf16x8 At[4][2], B0[2][2], B1[2][2];
    const GAS char* cA = (const GAS char*)g.A + (size_t)cur.pm * tstepA; const GAS char* cB = (const GAS char*)g.Bt + (size_t)cur.pn * tstepB;
    S.a_ready(cur);
    if constexpr (SP2) {
        PG8_STAGE(PG8_SB(0, 0), cB, voffB); PG8_STAGE(PG8_SB(0, 1), cB + hstepB, voffB); PG8_STAGE(PG8_SA(0, 0), cA, voffA); PG8_STAGE(PG8_SA(0, 1), cA + hstepA, voffA);
        if (wr == 1) PG8_BAR;
        PG8_WAIT_V(2); PG8_BAR;
        PG8_STAGE(PG8_SB(1, 0), cB + kstep, voffB); PG8_STAGE(PG8_SA(1, 0), cA + kstep, voffA); PG8_STAGE(PG8_SB(1, 1), cB + hstepB + kstep, voffB);
        PG8_WAIT_V(6); PG8_BAR;
    } else {
        PG8_STAGE(PG8_SB(0, 0), cB, voffB); PG8_STAGE(PG8_SA(0, 0), cA, voffA); PG8_STAGE(PG8_SB(0, 1), cB + hstepB, voffB); PG8_STAGE(PG8_SA(0, 1), cA + hstepA, voffA);
        if (wr == 1) PG8_BAR;
        PG8_WAIT_V(4); PG8_BAR;
        PG8_STAGE(PG8_SB(1, 0), cB + kstep, voffB); PG8_STAGE(PG8_SA(1, 0), cA + kstep, voffA); PG8_STAGE(PG8_SB(1, 1), cB + hstepB + kstep, voffB);
        PG8_WAIT_V(6); PG8_BAR;
    }
    for (;;) {
        const bool has_next = S.next(ui + 1, nxt);
        const GAS char* nA = has_next ? (const GAS char*)g.A + (size_t)nxt.pm * tstepA : cA; const GAS char* nB = has_next ? (const GAS char*)g.Bt + (size_t)nxt.pn * tstepB : cB;
        for (int t = 0; t < nt; t += 2) {
            const bool last = (t == nt - 2);
            const GAS char* a1 = cA + (size_t)(t + 1) * kstep;
            const GAS char* a2 = last ? nA : cA + (size_t)(t + 2) * kstep; const GAS char* b2 = last ? nB : cB + (size_t)(t + 2) * kstep;
            const GAS char* a3 = a2 + kstep; const GAS char* b3 = b2 + kstep;
            if (last && has_next) S.a_ready(nxt);
            if constexpr (SP2) {
            PG8_LDB(B0, 0, 0); PG8_LDB(B1, 0, 1); PG8_SCHED; PG8_LDA(At, 0, 0); PG8_STAGE(PG8_SA(1, 1), a1 + hstepA, voffA);
            PG8_WAIT_V(8); PG8_WAIT_L(0); PG8_BAR; PG8_MMA(0, 0, At, B0); PG8_MMA(0, 1, At, B1); PG8_BAR; PG8_SCHED;
            PG8_LDA(At, 0, 1); PG8_STAGE(PG8_SB(0, 0), b2, voffB); PG8_STAGE(PG8_SB(0, 1), b2 + hstepB, voffB); PG8_STAGE(PG8_SA(0, 0), a2, voffA);
            PG8_WAIT_V(8); PG8_WAIT_L(0); PG8_BAR; PG8_MMA(1, 0, At, B0); PG8_MMA(1, 1, At, B1); PG8_BAR; PG8_SCHED;
            PG8_LDB(B0, 1, 0); PG8_LDB(B1, 1, 1); PG8_SCHED; PG8_LDA(At, 1, 0); PG8_STAGE(PG8_SA(0, 1), a2 + hstepA, voffA);
            PG8_WAIT_V(8); PG8_WAIT_L(0); PG8_BAR; PG8_MMA(0, 0, At, B0); PG8_MMA(0, 1, At, B1); PG8_BAR; PG8_SCHED;
            PG8_LDA(At, 1, 1); PG8_STAGE(PG8_SB(1, 0), b3, voffB); PG8_STAGE(PG8_SB(1, 1), b3 + hstepB, voffB); PG8_STAGE(PG8_SA(1, 0), a3, voffA);
            PG8_WAIT_V(8); PG8_WAIT_L(0); PG8_BAR; PG8_MMA(1, 0, At, B0); PG8_MMA(1, 1, At, B1); PG8_BAR; PG8_SCHED;
            } else {
            PG8_LDB(B0, 0, 0); PG8_SCHED; PG8_LDA(At, 0, 0); PG8_STAGE(PG8_SA(1, 1), a1 + hstepA, voffA);
            PG8_WAIT_L(8); PG8_BAR; PG8_WAIT_L(0); PG8_MMA(0, 0, At, B0); PG8_BAR; PG8_SCHED;
            PG8_LDB(B1, 0, 1); PG8_STAGE(PG8_SB(0, 0), b2, voffB);
            PG8_BAR; PG8_WAIT_L(0); PG8_MMA(0, 1, At, B1); PG8_BAR;
            PG8_LDA(At, 0, 1); PG8_STAGE(PG8_SA(0, 0), a2, voffA);
            PG8_BAR; PG8_WAIT_L(0); PG8_MMA(1, 0, At, B0); PG8_BAR; PG8_SCHED;
            PG8_STAGE(PG8_SB(0, 1), b2 + hstepB, voffB);
            PG8_WAIT_V(6); PG8_BAR; PG8_MMA(1, 1, At, B1); PG8_BAR;
            PG8_LDB(B0, 1, 0); PG8_SCHED; PG8_LDA(At, 1, 0); PG8_STAGE(PG8_SA(0, 1), a2 + hstepA, voffA);
            PG8_WAIT_L(8); PG8_BAR; PG8_WAIT_L(0); PG8_MMA(0, 0, At, B0); PG8_BAR; PG8_SCHED;
            PG8_LDB(B1, 1, 1); PG8_STAGE(PG8_SB(1, 0), b3, voffB);
            PG8_BAR; PG8_WAIT_L(0); PG8_MMA(0, 1, At, B1); PG8_BAR;
            PG8_LDA(At, 1, 1); PG8_STAGE(PG8_SA(1, 0), a3, voffA);
            PG8_BAR; PG8_WAIT_L(0); PG8_MMA(1, 0, At, B0); PG8_BAR; PG8_SCHED;
            PG8_STAGE(PG8_SB(1, 1), b3 + hstepB, voffB);
            PG8_WAIT_V(6); PG8_BAR; PG8_MMA(1, 1, At, B1); PG8_BAR;
            }
        }
        if constexpr (ALIGN_EPI) { if (wr == 0) PG8_BAR; }
        if constexpr (!Epi::AFTER_DRAIN) { E(acc, cur, wr, wc, fr, fq); S.done(cur); }
        if (!has_next) break;
#pragma unroll
        for (int a = 0; a < 2; ++a)
#pragma unroll
            for (int b = 0; b < 2; ++b)
#pragma unroll
                for (int m = 0; m < 4; ++m)
#pragma unroll
                    for (int n = 0; n < 2; ++n) acc[a][b][m][n] = (f32x4){0.f, 0.f, 0.f, 0.f};
        cur = nxt; cA = nA; cB = nB; ++ui;
        if constexpr (ALIGN_EPI) { if (wr == 1) PG8_BAR; }
    }
    PG8_WAIT_V(0);
    if constexpr (!ALIGN_EPI) { if (wr == 0) PG8_BAR; }
    PG8_BAR;
    if constexpr (Epi::AFTER_DRAIN) { E.fused(acc, cur, wr, wc, fr, fq, lds, wid, lane); S.done(cur); }
#undef PG8_SA
#undef PG8_SB
#undef PG8_STAGE
#undef PG8_LDA
#undef PG8_LDB
#undef PG8_MMA
#undef PG8_WAIT_V
#undef PG8_WAIT_L
#undef PG8_BAR
#undef PG8_SCHED
}
}

#define LAS __attribute__((address_space(3)))
typedef pg8::bf16_t bf16_t;
typedef pg8::bf16x8 bf16x8;
typedef pg8::f32x4 f32x4;
typedef pg8::u32x4 u32x4;
typedef unsigned u32x2 __attribute__((ext_vector_type(2)));
using pg8::cvt_pk_bf16;

constexpr int DM = 1024, SEQL = 4096, NBATCH = 8, MROWS = NBATCH * SEQL, DFF = 2816;
constexpr int LDS_BYTES = 147456;
constexpr size_t SZ_FFN_IN = (size_t)5632 * 1024 * 2, SZ_FFN_OUT = (size_t)1024 * 2816 * 2, SZ_FFN = SZ_FFN_IN + SZ_FFN_OUT;
constexpr size_t SZ_GLA_IN = (size_t)3328 * 1024 * 2, SZ_GLA_OUT = (size_t)1024 * 1024 * 2, SZ_GLA = SZ_GLA_IN + SZ_GLA_OUT;
constexpr size_t SZ_SGU_IN = (size_t)6144 * 1024 * 2, SZ_SGU_OUT = (size_t)1024 * 3072 * 2;
constexpr size_t SZ_SWA_IN = (size_t)1280 * 1024 * 2, SZ_SWA_OUT = (size_t)1024 * 1024 * 2;
constexpr size_t WS_FFN = 0;
constexpr size_t WS_GLA = WS_FFN + 8 * SZ_FFN;
constexpr size_t WS_SGU = WS_GLA + 2 * SZ_GLA;
constexpr size_t WS_SWA = WS_SGU + SZ_SGU_IN + SZ_SGU_OUT;
constexpr size_t WS_XB = WS_SWA + SZ_SWA_IN + SZ_SWA_OUT;
constexpr size_t WS_TEMP = WS_XB + (size_t)MROWS * 1024 * 2;
constexpr size_t SZ_TEMP = (size_t)MROWS * 3328 * 2;
constexpr size_t WS_SSQ = WS_TEMP + SZ_TEMP;
constexpr size_t WS_LNSTAT = WS_SSQ + 13 * 4 * (size_t)MROWS * 4;
constexpr size_t WS_ROPE = WS_LNSTAT + (size_t)MROWS * 24 * 4;
constexpr size_t WS_DEC = WS_ROPE + (size_t)MROWS * 16 * 4;
constexpr size_t WS_END = WS_DEC + 16 * (size_t)MROWS * 4 * 4;
constexpr size_t WS_BAR = WS_END, WS_BAR_BYTES = 16384, WS_KST = WS_BAR + WS_BAR_BYTES, WS_PBUF = WS_KST + (size_t)2048 * 8192 * 2, WS_END2 = WS_PBUF + (size_t)2048 * 4096 * 2;
static_assert(WS_END2 <= (size_t)512 * 1024 * 1024, "workspace map");

struct Args { const float* in[52]; float* out; unsigned char* ws; };

__device__ __forceinline__ float bf2f(unsigned v) { return __builtin_bit_cast(float, v << 16); }
__device__ __forceinline__ float bflo(unsigned w) { return __builtin_bit_cast(float, w << 16); }
__device__ __forceinline__ float bfhi(unsigned w) { return __builtin_bit_cast(float, w & 0xffff0000u); }
__device__ __forceinline__ bf16_t f2bf(float f) { return __builtin_bit_cast(bf16_t, (__bf16)f); }
__device__ __forceinline__ f32x4 mfma16(bf16x8 a, bf16x8 b, f32x4 c) { return __builtin_amdgcn_mfma_f32_16x16x32_bf16(a, b, c, 0, 0, 0); }
__device__ __forceinline__ float wave_sum(float v) {
#pragma unroll
    for (int o = 1; o < 64; o <<= 1) v += __shfl_xor(v, o);
    return v;
}
__device__ __forceinline__ int layer_base(int L) { return L == 0 ? 2 : (L == 1 ? 14 : (L == 2 ? 27 : 39)); }
__device__ __forceinline__ GAS unsigned char* mixer_w(GAS unsigned char* ws, int L) { return ws + (L == 0 ? WS_GLA : (L == 3 ? WS_GLA + SZ_GLA : (L == 1 ? WS_SGU : WS_SWA))); }
__device__ __forceinline__ size_t mixer_in_sz(int L) { return L == 1 ? SZ_SGU_IN : (L == 2 ? SZ_SWA_IN : SZ_GLA_IN); }

typedef const __attribute__((address_space(4))) unsigned long long* KPTR;
#define ARGP(i) ((const GAS float*)kp[i])
struct MatDesc { const GAS float* src; const GAS float* gain; GAS bf16_t* dst; int K, N, mode; };
__device__ __forceinline__ MatDesc get_mat(KPTR kp, GAS unsigned char* ws, int mat) {
    const int L = mat / 6, j = mat % 6, base = layer_base(L), f2 = base + (L == 1 ? 10 : 9);
    MatDesc d;
    if (j == 0)      { d.src = ARGP(base + 1); d.gain = ARGP(base); d.dst = (GAS bf16_t*)(ws + WS_FFN + (size_t)(L * 2) * SZ_FFN); d.K = 1024; d.N = 5632; d.mode = 1; }
    else if (j == 1) { d.src = ARGP(base + 2); d.gain = nullptr;    d.dst = (GAS bf16_t*)(ws + WS_FFN + (size_t)(L * 2) * SZ_FFN + SZ_FFN_IN); d.K = 2816; d.N = 1024; d.mode = 0; }
    else if (j == 2) { d.src = ARGP(f2 + 1);   d.gain = ARGP(f2);   d.dst = (GAS bf16_t*)(ws + WS_FFN + (size_t)(L * 2 + 1) * SZ_FFN); d.K = 1024; d.N = 5632; d.mode = 1; }
    else if (j == 3) { d.src = ARGP(f2 + 2);   d.gain = nullptr;    d.dst = (GAS bf16_t*)(ws + WS_FFN + (size_t)(L * 2 + 1) * SZ_FFN + SZ_FFN_IN); d.K = 2816; d.N = 1024; d.mode = 0; }
    else if (j == 4) { d.src = ARGP(base + 4); d.gain = ARGP(base + 3); d.dst = (GAS bf16_t*)mixer_w(ws, L); d.K = 1024; d.N = (L == 1 ? 6144 : (L == 2 ? 1280 : 3088)); d.mode = 0; }
    else             { d.src = ARGP(base + (L == 1 ? 9 : (L == 2 ? 7 : 8))); d.gain = nullptr; d.dst = (GAS bf16_t*)(mixer_w(ws, L) + mixer_in_sz(L)); d.K = (L == 1 ? 3072 : 1024); d.N = 1024; d.mode = 0; }
    return d;
}
__device__ __forceinline__ int mat_items(int mat) {
    const int L = mat / 6, j = mat % 6;
    if (j == 0 || j == 2) return 16 * 88;
    if (j == 1 || j == 3) return 44 * 16;
    if (j == 4) return 16 * (L == 1 ? 96 : (L == 2 ? 20 : 49));
    return (L == 1 ? 48 : 16) * 16;
}
__device__ __forceinline__ void p0_transpose_item(const MatDesc& d, LAS float* scr, int item, int lane) {
    const int nblk = (d.N + 63) / 64, kb = item / nblk, nb = item % nblk, k0 = 64 * kb, n0 = 64 * nb, K = d.K, N = d.N;
    const int c4 = (lane & 15) * 4, r0 = lane >> 4, nn = n0 + c4;
    f32x4 v[16];
#pragma unroll
    for (int i = 0; i < 16; ++i) v[i] = (nn < N) ? *(const GAS f32x4*)(d.src + (size_t)(k0 + r0 + 4 * i) * N + nn) : (f32x4){0.f, 0.f, 0.f, 0.f};
    if (d.gain) {
#pragma unroll
        for (int i = 0; i < 16; ++i) v[i] = v[i] * d.gain[k0 + r0 + 4 * i]; }
#pragma unroll
    for (int i = 0; i < 16; ++i) { LAS float* p = scr + (r0 + 4 * i) * 65 + c4; p[0] = v[i][0]; p[1] = v[i][1]; p[2] = v[i][2]; p[3] = v[i][3]; }
    asm volatile("s_waitcnt lgkmcnt(0)" ::: "memory");
#pragma unroll
    for (int j = 0; j < 8; ++j) { const int id = lane + 64 * j, n = id >> 3, c = id & 7; const LAS float* sp = scr + (8 * c) * 65 + n;
        u32x4 o; o.x = cvt_pk_bf16(sp[0 * 65], sp[1 * 65]); o.y = cvt_pk_bf16(sp[2 * 65], sp[3 * 65]); o.z = cvt_pk_bf16(sp[4 * 65], sp[5 * 65]); o.w = cvt_pk_bf16(sp[6 * 65], sp[7 * 65]);
        const int ng = n0 + n; int row = ng;
        if (d.mode == 1) { row = (ng < 2816) ? ((ng >> 7) * 256 + (ng & 127)) : ((((ng - 2816) >> 7) * 256) + 128 + ((ng - 2816) & 127)); }
        *(GAS u32x4*)(d.dst + (size_t)row * K + k0 + 8 * c) = o; }
    asm volatile("s_waitcnt lgkmcnt(0)" ::: "memory");
}
__device__ __forceinline__ void p0_prologue(KPTR kp, GAS unsigned char* ws_, LAS unsigned char* lds, const int tid) {
    const int lane = tid & 63, wave = tid >> 6, G = gridDim.x;
    const int gw = blockIdx.x * 8 + wave, NGW = G * 8;
    const size_t gt = (size_t)blockIdx.x * 512 + tid, NGT = (size_t)G * 512;
    LAS float* scr = (LAS float*)(lds + wave * 16640);
    int total = 0;
    for (int m = 0; m < 24; ++m) total += mat_items(m);
    for (int it = gw; it < total; it += NGW) {
        int r = it, m = 0;
        for (; m < 23; ++m) { const int c = mat_items(m); if (r < c) break; r -= c; }
        const MatDesc d = get_mat(kp, ws_, m);
        p0_transpose_item(d, scr, r, lane);
    }
    for (size_t i = gt; i < 2 * (size_t)240 * 1024 / 8; i += NGT) { const int which = (int)(i / (240 * 128)); const size_t o = i % (240 * 128);
        *(GAS u32x4*)(ws_ + WS_GLA + (size_t)which * SZ_GLA + (size_t)3088 * 2048 + o * 16) = (u32x4){0u, 0u, 0u, 0u}; }
    { const GAS float* x = ARGP(0); GAS bf16_t* xb = (GAS bf16_t*)(ws_ + WS_XB); GAS float* ssq0 = (GAS float*)(ws_ + WS_SSQ);
      for (int r = gw; r < MROWS; r += NGW) {
        const GAS f32x4* xr = (const GAS f32x4*)(x + (size_t)r * 1024) + lane; float s = 0.f;
        GAS u32x2* o8 = (GAS u32x2*)(xb + (size_t)r * 1024) + lane;
#pragma unroll
        for (int j = 0; j < 4; ++j) { const f32x4 v = xr[64 * j]; s += (v[0] * v[0] + v[1] * v[1]) + (v[2] * v[2] + v[3] * v[3]);
            u32x2 w; w.x = cvt_pk_bf16(v[0], v[1]); w.y = cvt_pk_bf16(v[2], v[3]); o8[64 * j] = w; }
        s = wave_sum(s); if (lane < 4) ssq0[4 * (size_t)r + lane] = (lane == 0) ? s : 0.f; } }
    { const GAS int* pos = (const GAS int*)ARGP(1); GAS float* rope = (GAS float*)(ws_ + WS_ROPE);
      for (size_t i = gt; i < (size_t)MROWS * 8; i += NGT) { const int t = (int)(i >> 3), f = (int)(i & 7);
        const float inv = powf(500000.0f, -(float)f * 0.125f); const float ang = (float)pos[t] * inv;
        rope[(size_t)t * 16 + f] = cosf(ang); rope[(size_t)t * 16 + 8 + f] = sinf(ang); } }
}

__device__ __forceinline__ void gla_pre(LAS unsigned char* lds, GAS bf16_t* proj, GAS bf16_t* kst, GAS float* decb, GAS bf16_t* pbuf, const GAS float* w_up, const GAS float* b_gk, const int tid) {
    constexpr int QST = 136, JST = 72;
    const int lane = tid & 63, wave = tid >> 6, l15 = lane & 15, g4 = lane >> 4;
    LAS bf16_t* QD = (LAS bf16_t*)lds;
    LAS bf16_t* KI = QD + 64 * QST;
    LAS float* SEG = (LAS float*)(KI + 64 * QST);
    LAS float* GKS = SEG + 512;
    const int kch = tid & 127, jq = tid >> 7, mi = wave & 3, half = wave >> 2;
    for (int item = blockIdx.x; item < 2048; item += gridDim.x) {
        const int c = item & 63, h = (item >> 6) & 3, b = item >> 8;
        const size_t t0 = (size_t)b * SEQL + (size_t)c * 64;
        float wup[16];
#pragma unroll
        for (int r = 0; r < 16; ++r) wup[r] = w_up[r * 512 + h * 128 + kch];
        const float bg = b_gk[h * 128 + kch];
        u32x4 graw = (u32x4){0u, 0u, 0u, 0u};
        if (tid < 128) graw = *(const GAS u32x4*)(proj + (t0 + (tid >> 1)) * 3328 + 3072 + (tid & 1) * 8);
        unsigned short qr[16], kr[16];
#pragma unroll
        for (int jj = 0; jj < 16; ++jj) { const GAS bf16_t* rp = proj + (t0 + jq * 16 + jj) * 3328 + h * 128 + kch; qr[jj] = rp[0]; kr[jj] = rp[512]; }
        __syncthreads();
        if (tid < 128) { const int j = tid >> 1, hf = tid & 1; LAS float* gd = GKS + j * 16 + hf * 8;
            gd[0] = bflo(graw.x); gd[1] = bfhi(graw.x); gd[2] = bflo(graw.y); gd[3] = bfhi(graw.y); gd[4] = bflo(graw.z); gd[5] = bfhi(graw.z); gd[6] = bflo(graw.w); gd[7] = bfhi(graw.w); }
        asm volatile("s_waitcnt vmcnt(0)" ::: "memory");
        __syncthreads();
        float la[16]; float run = 0.f;
#pragma unroll
        for (int jj = 0; jj < 16; ++jj) { const LAS float* gr = GKS + (jq * 16 + jj) * 16; float z = bg;
#pragma unroll
            for (int r = 0; r < 16; ++r) z += gr[r] * wup[r];
            const float ls = fminf(z, 0.f) - __logf(1.0f + __expf(-fabsf(z)));
            run += ls * (1.0f / 16.0f); la[jj] = run; }
        SEG[jq * 128 + kch] = run;
        __syncthreads();
        const float s0 = SEG[kch], s1 = SEG[128 + kch], s2 = SEG[256 + kch], s3 = SEG[384 + kch];
        const float pre = (jq > 0 ? s0 : 0.f) + (jq > 1 ? s1 : 0.f) + (jq > 2 ? s2 : 0.f), tot = (s0 + s1) + (s2 + s3);
        unsigned ksp[8];
#pragma unroll
        for (int jj = 0; jj < 16; jj += 2) {
            float ksv[2];
#pragma unroll
            for (int e = 0; e < 2; ++e) { const int j = jq * 16 + jj + e; const float bb = la[jj + e] + pre; const float qf = bf2f(qr[jj + e]), kf = bf2f(kr[jj + e]);
                const bf16_t qd = f2bf(qf * 0.08838834764831845f * __expf(bb)), ki = f2bf(kf * __expf(-bb)); ksv[e] = kf * __expf(tot - bb);
                proj[(t0 + j) * 3328 + h * 128 + kch] = qd; QD[j * QST + kch] = qd; KI[j * QST + kch] = ki; }
            ksp[jj >> 1] = cvt_pk_bf16(ksv[0], ksv[1]); }
        { GAS u32x4* kd = (GAS u32x4*)(kst + (size_t)item * 8192 + kch * 64 + jq * 16); kd[0] = (u32x4){ksp[0], ksp[1], ksp[2], ksp[3]}; kd[1] = (u32x4){ksp[4], ksp[5], ksp[6], ksp[7]}; }
        if (jq == 0) decb[(size_t)item * 128 + kch] = __expf(tot);
        __syncthreads();
        f32x4 at[2] = {(f32x4){0.f, 0.f, 0.f, 0.f}, (f32x4){0.f, 0.f, 0.f, 0.f}};
#pragma unroll
        for (int ks = 0; ks < 4; ++ks) {
            const bf16x8 af = *(const LAS bf16x8*)(QD + (mi * 16 + l15) * QST + ks * 32 + 8 * g4);
#pragma unroll
            for (int t = 0; t < 2; ++t) { const bf16x8 bfr = *(const LAS bf16x8*)(KI + ((half * 2 + t) * 16 + l15) * QST + ks * 32 + 8 * g4); at[t] = mfma16(af, bfr, at[t]); }
        }
#pragma unroll
        for (int t = 0; t < 2; ++t)
#pragma unroll
            for (int r = 0; r < 4; ++r) { const int i = mi * 16 + g4 * 4 + r, j = (half * 2 + t) * 16 + l15; pbuf[(size_t)item * 4096 + i * 64 + j] = f2bf(j <= i ? at[t][r] : 0.f); }
    }
}
__device__ __forceinline__ void gla_core(LAS unsigned char* lds, const GAS bf16_t* proj, const GAS bf16_t* kst, const GAS float* decb, const GAS bf16_t* pbuf, GAS bf16_t* ost, const int tid) {
    const int lane = tid & 63, wave = tid >> 6, l15 = lane & 15, g4 = lane >> 4;
    constexpr int QST = 136, JST = 72;
    constexpr int OFF_PS = 64 * QST, OFF_KST = OFF_PS + 64 * JST, OFF_VT = OFF_KST + 128 * JST, OFF_DEC = OFF_VT + 32 * JST, BUF_EL = OFF_DEC + 256;
    LAS bf16_t* BUF = (LAS bf16_t*)lds;
    LAS bf16_t* STT = BUF + 2 * BUF_EL;
    const int mi = wave & 3, half = wave >> 2;
    for (int item = blockIdx.x; item < 256; item += gridDim.x) {
        const int vs = item & 7, h = (item >> 3) & 3, b = item >> 5;
        f32x4 st[2] = {(f32x4){0.f, 0.f, 0.f, 0.f}, (f32x4){0.f, 0.f, 0.f, 0.f}};
        __syncthreads();
        for (int i = tid; i < 32 * QST / 2; i += 512) ((LAS unsigned*)STT)[i] = 0u;
        u32x4 rq[2], rs[2], rp, rv = (u32x4){0u, 0u, 0u, 0u}; float rd = 0.f;
#define GLA_LOAD(cn) do { const size_t tn = (size_t)b * SEQL + (size_t)(cn) * 64; const size_t ci = (size_t)((b * 4 + h) * 64 + (cn)); \
            _Pragma("unroll") for (int q = 0; q < 2; ++q) { const int id = tid + 512 * q; \
                rq[q] = *(const GAS u32x4*)(proj + (tn + (id >> 4)) * 3328 + h * 128 + (id & 15) * 8); rs[q] = *(const GAS u32x4*)(kst + ci * 8192 + (size_t)id * 8); } \
            rp = *(const GAS u32x4*)(pbuf + ci * 4096 + (size_t)tid * 8); \
            if (tid < 256) rv = *(const GAS u32x4*)(proj + (tn + (tid >> 2)) * 3328 + 1024 + h * 256 + vs * 32 + (tid & 3) * 8); \
            if (tid < 128) rd = decb[ci * 128 + tid]; } while (0)
        GLA_LOAD(0);
        for (int c = 0; c < 64; ++c) {
            LAS bf16_t* QD = BUF + (c & 1) * BUF_EL; LAS bf16_t* PS = QD + OFF_PS; LAS bf16_t* KST = QD + OFF_KST; LAS bf16_t* VT = QD + OFF_VT; LAS float* DEC = (LAS float*)(QD + OFF_DEC);
            const LAS bf16_t* STR = STT + (c & 1) * 32 * QST; LAS bf16_t* STW = STT + ((c + 1) & 1) * 32 * QST;
#pragma unroll
            for (int q = 0; q < 2; ++q) { const int id = tid + 512 * q;
                *(LAS u32x4*)(QD + (id >> 4) * QST + (id & 15) * 8) = rq[q]; *(LAS u32x4*)(KST + (id >> 3) * JST + (id & 7) * 8) = rs[q]; }
            *(LAS u32x4*)(PS + (tid >> 3) * JST + (tid & 7) * 8) = rp;
            if (tid < 256) { const int j = tid >> 2, ch = tid & 3; LAS bf16_t* vd = VT + (ch * 8) * JST + j;
                vd[0 * JST] = (bf16_t)(rv.x & 0xffffu); vd[1 * JST] = (bf16_t)(rv.x >> 16); vd[2 * JST] = (bf16_t)(rv.y & 0xffffu); vd[3 * JST] = (bf16_t)(rv.y >> 16);
                vd[4 * JST] = (bf16_t)(rv.z & 0xffffu); vd[5 * JST] = (bf16_t)(rv.z >> 16); vd[6 * JST] = (bf16_t)(rv.w & 0xffffu); vd[7 * JST] = (bf16_t)(rv.w >> 16); }
            if (tid < 128) DEC[tid] = rd;
            if (c + 1 < 64) GLA_LOAD(c + 1);
            __syncthreads();
            f32x4 oacc = (f32x4){0.f, 0.f, 0.f, 0.f};
#pragma unroll
            for (int ks = 0; ks < 4; ++ks) { const bf16x8 af = *(const LAS bf16x8*)(QD + (mi * 16 + l15) * QST + ks * 32 + 8 * g4);
                const bf16x8 sfr = *(const LAS bf16x8*)(STR + (half * 16 + l15) * QST + ks * 32 + 8 * g4); oacc = mfma16(af, sfr, oacc); }
#pragma unroll
            for (int ks = 0; ks < 2; ++ks) { const bf16x8 af = *(const LAS bf16x8*)(PS + (mi * 16 + l15) * JST + ks * 32 + 8 * g4);
                const bf16x8 bfr = *(const LAS bf16x8*)(VT + (half * 16 + l15) * JST + ks * 32 + 8 * g4); oacc = mfma16(af, bfr, oacc); }
#pragma unroll
            for (int r = 0; r < 4; ++r) { const int i = mi * 16 + g4 * 4 + r;
                ost[(size_t)item * 131072 + (size_t)(c * 64 + i) * 32 + half * 16 + l15] = f2bf(oacc[r]); }
            { const float dc = DEC[wave * 16 + l15];
#pragma unroll
              for (int vt = 0; vt < 2; ++vt) { st[vt] = st[vt] * dc;
#pragma unroll
                for (int ks = 0; ks < 2; ++ks) { const bf16x8 af = *(const LAS bf16x8*)(VT + (vt * 16 + l15) * JST + ks * 32 + 8 * g4);
                    const bf16x8 bfr = *(const LAS bf16x8*)(KST + (wave * 16 + l15) * JST + ks * 32 + 8 * g4); st[vt] = mfma16(af, bfr, st[vt]); }
#pragma unroll
                for (int r = 0; r < 4; ++r) STW[(vt * 16 + g4 * 4 + r) * QST + wave * 16 + l15] = f2bf(st[vt][r]); } }
        }
#undef GLA_LOAD
    }
}
__device__ __forceinline__ void gla_post(GAS bf16_t* proj, const GAS bf16_t* ost, const GAS float* o_norm, const int tid) {
    const int lane = tid & 63, wave = tid >> 6;
    const int gw = blockIdx.x * 8 + wave, NGW = gridDim.x * 8;
    float gn[16];
#pragma unroll
    for (int e = 0; e < 16; ++e) gn[e] = o_norm[(lane & 15) * 16 + e];
    for (int r = gw; r < MROWS; r += NGW) {
        const int b = r >> 12, t = r & 4095, h = lane >> 4, p = lane & 15;
        const GAS u32x4* op = (const GAS u32x4*)(ost + (size_t)((b * 4 + h) * 8 + (p >> 1)) * 131072 + (size_t)t * 32 + (p & 1) * 16);
        GAS u32x4* dp = (GAS u32x4*)(proj + (size_t)r * 3328 + 1024 + lane * 16); const GAS u32x4* rp = (const GAS u32x4*)(proj + (size_t)r * 3328 + 2048 + lane * 16);
        const u32x4 ov0 = op[0], ov1 = op[1];
        float hs = 0.f;
#pragma unroll
        for (int e = 0; e < 4; ++e) { const float a0 = bflo(ov0[e]), a1 = bfhi(ov0[e]), c0 = bflo(ov1[e]), c1 = bfhi(ov1[e]); hs += (a0 * a0 + a1 * a1) + (c0 * c0 + c1 * c1); }
        hs += __shfl_xor(hs, 1); hs += __shfl_xor(hs, 2); hs += __shfl_xor(hs, 4); hs += __shfl_xor(hs, 8);
        const float rs = __builtin_amdgcn_rsqf(hs * (1.0f / 256.0f) + pg8::RMS_EPS);
#pragma unroll
        for (int q = 0; q < 2; ++q) { const u32x4 ov = q ? ov1 : ov0, rv = rp[q]; u32x4 w;
#pragma unroll
            for (int e = 0; e < 4; ++e) { const float o0 = bflo(ov[e]), o1 = bfhi(ov[e]), r0 = bflo(rv[e]), r1 = bfhi(rv[e]);
                w[e] = cvt_pk_bf16(o0 * rs * gn[q * 8 + 2 * e] * pg8::silu_f(r0), o1 * rs * gn[q * 8 + 2 * e + 1] * pg8::silu_f(r1)); }
            dp[q] = w; }
    }
}

__device__ __forceinline__ void sgu_spatial(LAS unsigned char* lds, GAS bf16_t* uv  , const GAS float* lnstat  , int row0,
                                            const GAS float* ln_g, const GAS float* ln_b, const GAS float* w_s, const GAS float* b_s, const int tid) {
    const int lane = tid & 63, wave = tid >> 6, l15 = lane & 15, g4 = lane >> 4;
    constexpr int ST = 136;
    LAS bf16_t* WS = (LAS bf16_t*)lds;
    LAS bf16_t* VT = WS + 128 * ST;
    LAS float* STAT = (LAS float*)(VT + 384 * ST);
    int gcur = -1;
    for (int item = blockIdx.x; item < 1024; item += gridDim.x) {
        const int cc = item >> 3, g = item & 7;
        __syncthreads();
        if (g != gcur) { gcur = g;
            for (int idx = tid; idx < 128 * 32; idx += 512) { const int i = idx >> 5, j4 = (idx & 31) * 4;
                const f32x4 w = *(const GAS f32x4*)(w_s + (size_t)g * 16384 + i * 128 + j4);
                u32x2 o; o.x = cvt_pk_bf16(j4 <= i ? w[0] : 0.f, j4 + 1 <= i ? w[1] : 0.f); o.y = cvt_pk_bf16(j4 + 2 <= i ? w[2] : 0.f, j4 + 3 <= i ? w[3] : 0.f);
                *(LAS u32x2*)(WS + i * ST + j4) = o; } }
        if (tid < 128) { const GAS f32x4* lp = (const GAS f32x4*)(lnstat + 24 * (size_t)(row0 + cc * 128 + tid)); float s1 = 0.f, s2 = 0.f;
#pragma unroll
            for (int q = 0; q < 6; ++q) { const f32x4 v = lp[q]; s1 += v[0] + v[2]; s2 += v[1] + v[3]; }
            const float mean = s1 * (1.0f / 3072.0f), var = s2 * (1.0f / 3072.0f) - mean * mean;
            STAT[2 * tid] = mean; STAT[2 * tid + 1] = __builtin_amdgcn_rsqf(fmaxf(var, 0.f) + pg8::RMS_EPS); }
        __syncthreads();
        for (int idx = tid; idx < 32 * 48; idx += 512) { const int jg = idx / 48, ch = idx % 48, j0 = jg * 4;
            const f32x4 ga = *(const GAS f32x4*)(ln_g + g * 384 + ch * 8), gb = *(const GAS f32x4*)(ln_g + g * 384 + ch * 8 + 4);
            const f32x4 ba = *(const GAS f32x4*)(ln_b + g * 384 + ch * 8), bb = *(const GAS f32x4*)(ln_b + g * 384 + ch * 8 + 4);
            float vn[4][8];
#pragma unroll
            for (int q = 0; q < 4; ++q) { const int tl = cc * 128 + j0 + q;
                const u32x4 raw = *(const GAS u32x4*)(uv + (size_t)tl * 6144 + 3072 + g * 384 + ch * 8);
                const float mean = STAT[2 * (j0 + q)], rs = STAT[2 * (j0 + q) + 1];
                vn[q][0] = (bflo(raw.x) - mean) * rs * ga[0] + ba[0]; vn[q][1] = (bfhi(raw.x) - mean) * rs * ga[1] + ba[1];
                vn[q][2] = (bflo(raw.y) - mean) * rs * ga[2] + ba[2]; vn[q][3] = (bfhi(raw.y) - mean) * rs * ga[3] + ba[3];
                vn[q][4] = (bflo(raw.z) - mean) * rs * gb[0] + bb[0]; vn[q][5] = (bfhi(raw.z) - mean) * rs * gb[1] + bb[1];
                vn[q][6] = (bflo(raw.w) - mean) * rs * gb[2] + bb[2]; vn[q][7] = (bfhi(raw.w) - mean) * rs * gb[3] + bb[3]; }
#pragma unroll
            for (int e = 0; e < 8; ++e) { u32x2 o; o.x = cvt_pk_bf16(vn[0][e], vn[1][e]); o.y = cvt_pk_bf16(vn[2][e], vn[3][e]); *(LAS u32x2*)(VT + (ch * 8 + e) * ST + (((j0 >> 2) ^ ((ch & 7) << 1)) << 2)) = o; } }
        __syncthreads();
        f32x4 acc[8][3];
#pragma unroll
        for (int mt = 0; mt < 8; ++mt)
#pragma unroll
            for (int nt = 0; nt < 3; ++nt) acc[mt][nt] = (f32x4){0.f, 0.f, 0.f, 0.f};
#pragma unroll
        for (int ks = 0; ks < 4; ++ks) {
            bf16x8 bfr[3];
#pragma unroll
            for (int nt = 0; nt < 3; ++nt) { const int row = wave * 48 + nt * 16 + l15; bfr[nt] = *(const LAS bf16x8*)(VT + row * ST + (((ks * 4 + g4) ^ ((row >> 3) & 7)) << 3)); }
#pragma unroll
            for (int mt = 0; mt < 8; ++mt) { if (ks * 32 <= mt * 16 + 15) {
                const bf16x8 af = *(const LAS bf16x8*)(WS + (mt * 16 + l15) * ST + ks * 32 + 8 * g4);
#pragma unroll
                for (int nt = 0; nt < 3; ++nt) acc[mt][nt] = mfma16(bfr[nt], af, acc[mt][nt]); } }
        }
        u32x2 uuv[8][3]; float bsv[8];
#pragma unroll
        for (int mt = 0; mt < 8; ++mt) { const int i = mt * 16 + l15; bsv[mt] = b_s[g * 128 + i];
            const GAS bf16_t* up = uv + (size_t)(cc * 128 + i) * 6144 + g * 384 + wave * 48 + g4 * 4;
#pragma unroll
            for (int nt = 0; nt < 3; ++nt) uuv[mt][nt] = *(const GAS u32x2*)(up + nt * 16); }
#pragma unroll
        for (int mt = 0; mt < 8; ++mt) { const int i = mt * 16 + l15; const float bs = bsv[mt];
            GAS bf16_t* up = uv + (size_t)(cc * 128 + i) * 6144 + g * 384 + wave * 48 + g4 * 4;
#pragma unroll
            for (int nt = 0; nt < 3; ++nt) { const u32x2 uu = uuv[mt][nt]; u32x2 o;
                o.x = cvt_pk_bf16(bflo(uu.x) * (acc[mt][nt][0] + bs), bfhi(uu.x) * (acc[mt][nt][1] + bs)); o.y = cvt_pk_bf16(bflo(uu.y) * (acc[mt][nt][2] + bs), bfhi(uu.y) * (acc[mt][nt][3] + bs));
                *(GAS u32x2*)(up + nt * 16) = o; } }
    }
}

__device__ __forceinline__ u32x4 rope8(const GAS bf16_t* p16  , const GAS float* cs  , bool second) {
    const u32x4 x1 = *(const GAS u32x4*)p16, x2 = *(const GAS u32x4*)(p16 + 8);
    const f32x4 c0 = *(const GAS f32x4*)cs, c1 = *(const GAS f32x4*)(cs + 4), s0 = *(const GAS f32x4*)(cs + 8), s1 = *(const GAS f32x4*)(cs + 12);
    float o[8];
#pragma unroll
    for (int e = 0; e < 4; ++e) {
        const float a0 = bflo(x1[e]), a1 = bfhi(x1[e]), b0 = bflo(x2[e]), b1 = bfhi(x2[e]);
        const float cc0 = (e < 2) ? c0[2 * e] : c1[2 * e - 4], cc1 = (e < 2) ? c0[2 * e + 1] : c1[2 * e - 3];
        const float ss0 = (e < 2) ? s0[2 * e] : s1[2 * e - 4], ss1 = (e < 2) ? s0[2 * e + 1] : s1[2 * e - 3];
        o[2 * e] = second ? (b0 * cc0 + a0 * ss0) : (a0 * cc0 - b0 * ss0);
        o[2 * e + 1] = second ? (b1 * cc1 + a1 * ss1) : (a1 * cc1 - b1 * ss1);
    }
    u32x4 w; w.x = cvt_pk_bf16(o[0], o[1]); w.y = cvt_pk_bf16(o[2], o[3]); w.z = cvt_pk_bf16(o[4], o[5]); w.w = cvt_pk_bf16(o[6], o[7]); return w;
}
__device__ __forceinline__ void swa_attn(LAS unsigned char* lds, const GAS bf16_t* qkv  , GAS bf16_t* ao  , const GAS float* rope, const GAS float* sinks, const int tid) {
    const int lane = tid & 63, wave = tid >> 6, l15 = lane & 15, g4 = lane >> 4;
    constexpr int KSTR = 72, VSTR = 264, PSTR = 168;
    LAS bf16_t* Ks = (LAS bf16_t*)lds;
    LAS bf16_t* Vt = Ks + 256 * KSTR;
    LAS bf16_t* Ps = Vt + 64 * VSTR + wave * 16 * PSTR;
    for (int item = blockIdx.x; item < 512; item += gridDim.x) {
        const int kvh = item & 1, n = (item >> 1) & 31, b = item >> 6;
        const int tok0 = b * SEQL + n * 128;
        __syncthreads();
        for (int idx = tid; idx < 256 * 8; idx += 512) {
            const int jb = idx >> 3, ch = idx & 7; const int tok = tok0 - 128 + jb;
            u32x4 kq = (u32x4){0u, 0u, 0u, 0u}, vq = (u32x4){0u, 0u, 0u, 0u};
            if (n > 0 || jb >= 128) {
                const GAS bf16_t* krow = qkv + (size_t)tok * 1280 + 1024 + kvh * 64;
                vq = *(const GAS u32x4*)(qkv + (size_t)tok * 1280 + 1152 + kvh * 64 + ch * 8);
                if (ch < 2) kq = rope8(krow, rope + (size_t)tok * 16, ch == 1); else kq = *(const GAS u32x4*)(krow + ch * 8);
            }
            *(LAS u32x4*)(Ks + jb * KSTR + ch * 8) = kq;
            LAS bf16_t* vd = Vt + (ch * 8) * VSTR + jb;
            vd[0 * VSTR] = (bf16_t)(vq.x & 0xffffu); vd[1 * VSTR] = (bf16_t)(vq.x >> 16); vd[2 * VSTR] = (bf16_t)(vq.y & 0xffffu); vd[3 * VSTR] = (bf16_t)(vq.y >> 16);
            vd[4 * VSTR] = (bf16_t)(vq.z & 0xffffu); vd[5 * VSTR] = (bf16_t)(vq.z >> 16); vd[6 * VSTR] = (bf16_t)(vq.w & 0xffffu); vd[7 * VSTR] = (bf16_t)(vq.w >> 16);
        }
        __syncthreads();
        const int hq = kvh * 8 + wave; const float sink = sinks[hq];
        for (int i = 0; i < 8; ++i) {
            const int qtok = tok0 + 16 * i + l15; const GAS bf16_t* qp = qkv + (size_t)qtok * 1280 + hq * 64;
            bf16x8 qa[2];
            qa[1] = *(const GAS bf16x8*)(qp + 32 + 8 * g4);
            { u32x4 q0; if (g4 < 2) q0 = rope8(qp, rope + (size_t)qtok * 16, g4 == 1); else q0 = *(const GAS u32x4*)(qp + 8 * g4); qa[0] = __builtin_bit_cast(bf16x8, q0); }
            const int t0 = (i < 6) ? i : 6;
            f32x4 s[10];
#pragma unroll
            for (int nt = 0; nt < 10; ++nt) { s[nt] = (f32x4){0.f, 0.f, 0.f, 0.f};
#pragma unroll
                for (int ks = 0; ks < 2; ++ks) { const bf16x8 kb = *(const LAS bf16x8*)(Ks + ((t0 + nt) * 16 + l15) * KSTR + ks * 32 + 8 * g4); s[nt] = mfma16(qa[ks], kb, s[nt]); } }
            float inv[4];
#pragma unroll
            for (int r = 0; r < 4; ++r) {
                const int ql = 16 * i + g4 * 4 + r; float mx = sink;
#pragma unroll
                for (int nt = 0; nt < 10; ++nt) { const int jb = (t0 + nt) * 16 + l15; const bool ok = (jb > ql) && (jb <= ql + 128) && (n > 0 || jb >= 128);
                    const float v = ok ? s[nt][r] * 0.125f : -INFINITY; s[nt][r] = v; mx = fmaxf(mx, v); }
                mx = fmaxf(mx, __shfl_xor(mx, 1)); mx = fmaxf(mx, __shfl_xor(mx, 2)); mx = fmaxf(mx, __shfl_xor(mx, 4)); mx = fmaxf(mx, __shfl_xor(mx, 8));
                float sum = 0.f;
#pragma unroll
                for (int nt = 0; nt < 10; ++nt) { const float p = __expf(s[nt][r] - mx); sum += p; Ps[(g4 * 4 + r) * PSTR + nt * 16 + l15] = f2bf(p); }
                sum += __shfl_xor(sum, 1); sum += __shfl_xor(sum, 2); sum += __shfl_xor(sum, 4); sum += __shfl_xor(sum, 8);
                inv[r] = 1.0f / (sum + __expf(sink - mx));
            }
            asm volatile("s_waitcnt lgkmcnt(0)" ::: "memory");
            f32x4 o[4] = {(f32x4){0.f, 0.f, 0.f, 0.f}, (f32x4){0.f, 0.f, 0.f, 0.f}, (f32x4){0.f, 0.f, 0.f, 0.f}, (f32x4){0.f, 0.f, 0.f, 0.f}};
#pragma unroll
            for (int ks = 0; ks < 5; ++ks) { const bf16x8 pa = *(const LAS bf16x8*)(Ps + l15 * PSTR + ks * 32 + 8 * g4);
#pragma unroll
                for (int dt = 0; dt < 4; ++dt) { const bf16x8 vb = *(const LAS bf16x8*)(Vt + (dt * 16 + l15) * VSTR + t0 * 16 + ks * 32 + 8 * g4); o[dt] = mfma16(pa, vb, o[dt]); } }
            asm volatile("s_waitcnt lgkmcnt(0)" ::: "memory");
#pragma unroll
            for (int r = 0; r < 4; ++r) { GAS bf16_t* op = ao + (size_t)(tok0 + 16 * i + g4 * 4 + r) * 1024 + hq * 64 + l15;
#pragma unroll
                for (int dt = 0; dt < 4; ++dt) op[dt * 16] = f2bf(o[dt][r] * inv[r]); }
        }
    }
}

__device__ __forceinline__ void final_norm(const GAS bf16_t* xb, GAS float* out, const GAS float* ssq, const GAS float* gain, const int tid) {
    const int lane = tid & 63, wave = tid >> 6, gw = blockIdx.x * 8 + wave, NGW = gridDim.x * 8;
    f32x4 gv[4];
#pragma unroll
    for (int j = 0; j < 4; ++j) gv[j] = *((const GAS f32x4*)(gain + lane * 16) + j);
    for (int r = gw; r < MROWS; r += NGW) { const float rs = __builtin_amdgcn_rsqf(pg8::ssq4(ssq, r) * (1.0f / 1024.0f) + pg8::RMS_EPS);
        const GAS u32x4* xp = (const GAS u32x4*)(xb + (size_t)r * 1024 + lane * 16); GAS f32x4* op = (GAS f32x4*)(out + (size_t)r * 1024 + lane * 16);
        const u32x4 a = xp[0], b = xp[1];
        op[0] = (f32x4){bflo(a.x), bfhi(a.x), bflo(a.y), bfhi(a.y)} * rs * gv[0]; op[1] = (f32x4){bflo(a.z), bfhi(a.z), bflo(a.w), bfhi(a.w)} * rs * gv[1];
        op[2] = (f32x4){bflo(b.x), bfhi(b.x), bflo(b.y), bfhi(b.y)} * rs * gv[2]; op[3] = (f32x4){bflo(b.z), bfhi(b.z), bflo(b.w), bfhi(b.w)} * rs * gv[3]; }
}

#define XB_TMO      128
#define XB_XCNT(j)  (256  + 64 * (j))
#define XB_XSUB(j)  (1280 + 64 * (j))
#define XB_XGEN(j)  (2304 + 64 * (j))
#define XB_TOP      3328
#define XB_TOPGEN   3392
#define XCD_BAR_WORDS 3456
#define XB_SPIN_CAP (1u << 18)

__device__ __forceinline__ unsigned xb_ld(unsigned* p)              { return __hip_atomic_load(p, __ATOMIC_RELAXED, __HIP_MEMORY_SCOPE_AGENT); }
__device__ __forceinline__ unsigned xb_add(unsigned* p, unsigned v) { return __hip_atomic_fetch_add(p, v, __ATOMIC_RELAXED, __HIP_MEMORY_SCOPE_AGENT); }
__device__ __forceinline__ unsigned xb_xcc_id() { return (unsigned)__builtin_amdgcn_s_getreg((3 << 11) | 20) & 0xFu; }
#define XB_SPIN(cond, bar) do { unsigned _sp = 0; while (cond) { __builtin_amdgcn_s_sleep(1); \
    if ((++_sp & 255u) == 0u) { if (xb_ld(&(bar)[XB_TMO])) break; if (_sp > XB_SPIN_CAP) { atomicAdd(&(bar)[XB_TMO], 1u); break; } } } } while (0)

struct XcdBarrier {
    unsigned* bar; unsigned x;
    volatile LAS unsigned* st;
};

__device__ __forceinline__ XcdBarrier xcd_barrier_post(unsigned* bar, volatile LAS unsigned* st) {
    XcdBarrier b; b.bar = bar; b.x = xb_xcc_id(); b.st = st;
    if (threadIdx.x == 0) (void)xb_add(&bar[XB_XCNT(b.x)], 1u);
    return b;
}
__device__ __forceinline__ void xcd_barrier_complete(unsigned* bar, unsigned x, unsigned& nloc, unsigned& nx) {
    const unsigned G = gridDim.x * gridDim.y * gridDim.z;
    unsigned sum, cnt, mine, sp = 0u;
    for (;;) {
        sum = 0u; cnt = 0u; mine = 0u;
#pragma unroll
        for (unsigned j = 0; j < 16; ++j) { const unsigned c = xb_ld(&bar[XB_XCNT(j)]); sum += c; cnt += (c > 0u) ? 1u : 0u; mine = (j == x) ? c : mine; }
        if (sum == G) break;
        __builtin_amdgcn_s_sleep(1);
        if ((++sp & 255u) == 0u) { if (xb_ld(&bar[XB_TMO])) break; if (sp > XB_SPIN_CAP) { atomicAdd(&bar[XB_TMO], 1u); break; } }
    }
    nloc = mine > 0u ? mine : 1u; nx = cnt > 0u ? cnt : 1u;
}

__device__ __forceinline__ void xcd_barrier(const XcdBarrier& b) {
    asm volatile("s_waitcnt vmcnt(0)" ::: "memory");
    __syncthreads();
    if (threadIdx.x == 0) {
        unsigned* bar = b.bar;
        __builtin_amdgcn_s_waitcnt(0);
        unsigned nloc = b.st[0], nx = b.st[1];
        if (nloc == 0u) { xcd_barrier_complete(bar, b.x, nloc, nx); b.st[0] = nloc; b.st[1] = nx; }
        const unsigned old = xb_add(&bar[XB_XSUB(b.x)], 1u);
        const unsigned gen = old / nloc;
        if (old + 1u == (gen + 1u) * nloc) {
            __builtin_amdgcn_fence(__ATOMIC_RELEASE, "agent");
            asm volatile("s_waitcnt vmcnt(0)" ::: "memory");
            const unsigned og = xb_add(&bar[XB_TOP], 1u);
            const unsigned tg = og / nx;
            if (og + 1u == (tg + 1u) * nx) xb_add(&bar[XB_TOPGEN], 1u);
            else XB_SPIN(xb_ld(&bar[XB_TOPGEN]) == tg, bar);
            __builtin_amdgcn_fence(__ATOMIC_ACQUIRE, "agent");
            xb_add(&bar[XB_XGEN(b.x)], 1u);
            asm volatile("s_waitcnt vmcnt(0)" ::: "memory");
        } else {
            XB_SPIN(xb_ld(&bar[XB_XGEN(b.x)]) == gen, bar);
            __builtin_amdgcn_fence(__ATOMIC_ACQUIRE, "agent");
            asm volatile("s_waitcnt vmcnt(0)" ::: "memory");
        }
    }
    __syncthreads();
}

#define OPW(k, l, s, h) ((unsigned short)((k) | ((l) << 4) | ((s) << 8) | ((h) << 9)))
constexpr int NOPS = 37;
__constant__ unsigned short OPS[NOPS] = {
    OPW(0,0,0,0),
    OPW(1,0,0,0), OPW(2,0,0,0), OPW(3,0,0,0), OPW(12,0,0,0), OPW(5,0,0,0), OPW(6,0,0,0), OPW(4,0,0,0), OPW(1,0,1,0), OPW(2,0,1,0),
    OPW(1,1,0,0), OPW(2,1,0,0), OPW(3,1,0,0), OPW(7,1,0,0), OPW(4,1,0,0), OPW(3,1,0,1), OPW(7,1,0,1), OPW(4,1,0,1), OPW(1,1,1,0), OPW(2,1,1,0),
    OPW(1,2,0,0), OPW(2,2,0,0), OPW(3,2,0,0), OPW(8,2,0,0), OPW(4,2,0,0), OPW(1,2,1,0), OPW(2,2,1,0),
    OPW(1,3,0,0), OPW(2,3,0,0), OPW(3,3,0,0), OPW(12,3,0,0), OPW(5,3,0,0), OPW(6,3,0,0), OPW(4,3,0,0), OPW(1,3,1,0), OPW(2,3,1,0),
    OPW(9,0,0,0) };

__global__ void __launch_bounds__(512, 2) mega_fwd(Args a) {
    extern __shared__ __attribute__((aligned(16))) unsigned char lds_raw[];
    LAS unsigned char* lds = (LAS unsigned char*)lds_raw;
    cg::grid_group grid = cg::this_grid();
    const int G = gridDim.x;
    volatile LAS unsigned* barst = (volatile LAS unsigned*)(lds + LDS_BYTES - 16);
    if (threadIdx.x < 4) barst[threadIdx.x] = 0u;
    __syncthreads();
    (void)xcd_barrier_post((unsigned*)(a.ws + WS_BAR), barst);
    for (int op = 0; op < NOPS; ++op) {
        int tid; asm volatile("v_mov_b32 %0, %1" : "=v"(tid) : "v"((int)threadIdx.x));
        KPTR kp = (KPTR)__builtin_amdgcn_kernarg_segment_ptr(); asm volatile("" : "+s"(kp));
        GAS unsigned char* ws = (GAS unsigned char*)kp[53]; GAS float* outp = (GAS float*)kp[52];
        GAS bf16_t* xb = (GAS bf16_t*)(ws + WS_XB); GAS bf16_t* temp = (GAS bf16_t*)(ws + WS_TEMP);
        GAS float* ssq = (GAS float*)(ws + WS_SSQ); GAS float* lnstat = (GAS float*)(ws + WS_LNSTAT);
        const unsigned w = OPS[op]; const int kind = w & 15, L = (w >> 4) & 3, sub = (w >> 8) & 1, hf = (w >> 9) & 1;
        const int base = layer_base(L);
        if (kind == 0) { p0_prologue(kp, ws, lds, tid); }
        else if (kind == 1) {
            pg8::Gemm g{xb, (const GAS bf16_t*)(ws + WS_FFN + (size_t)(L * 2 + sub) * SZ_FFN), MROWS, 5632, 1024, 1024};
            pg8::StaticOrder S; S.init(MROWS, 5632, G, (int)blockIdx.x);
            pg8::EpiSwiGLU E{temp, DFF, ssq + (size_t)(3 * L + 2 * sub) * 4 * MROWS};
            pg8::gemm_phase<pg8::EpiSwiGLU, pg8::StaticOrder, true, true>(lds, g, S, E, tid);
        } else if (kind == 2) {
            pg8::Gemm g{temp, (const GAS bf16_t*)(ws + WS_FFN + (size_t)(L * 2 + sub) * SZ_FFN + SZ_FFN_IN), MROWS, 1024, 2816, 2816};
            pg8::StaticOrder S; S.init(MROWS, 1024, G, (int)blockIdx.x);
            pg8::EpiRes E{xb, ssq + (size_t)(3 * L + 2 * sub + 1) * 4 * MROWS, nullptr, 0.5f, 0, (LAS float*)(lds + 131072), tid};
            pg8::gemm_phase<pg8::EpiRes, pg8::StaticOrder, true, true>(lds, g, S, E, tid);
        } else if (kind == 3) {
            const GAS bf16_t* Bt = (const GAS bf16_t*)mixer_w(ws, L);
            const int Mh = (L == 1) ? MROWS / 2 : MROWS, N = (L == 1) ? 6144 : (L == 2 ? 1280 : 3328), row0 = hf * (MROWS / 2);
            pg8::Gemm g{xb + (size_t)row0 * 1024, Bt, Mh, N, 1024, 1024};
            pg8::StaticOrder S; S.init(Mh, N, G, (int)blockIdx.x);
            pg8::EpiPlain E{temp, N, ssq + (size_t)(3 * L + 1) * 4 * MROWS, (L == 2) ? ARGP(32) : nullptr, (L == 1) ? 1 : 0, (L == 1) ? lnstat : nullptr, 12, row0, (LAS float*)(lds + 131072), tid};
            pg8::gemm_phase<pg8::EpiPlain, pg8::StaticOrder, true, true>(lds, g, S, E, tid);
        } else if (kind == 4) {
            const GAS bf16_t* Bt = (const GAS bf16_t*)(mixer_w(ws, L) + mixer_in_sz(L));
            const int Mh = (L == 1) ? MROWS / 2 : MROWS, K = (L == 1) ? 3072 : 1024, row0 = hf * (MROWS / 2);
            const GAS bf16_t* A = (L == 1) ? temp : (L == 2 ? temp + (size_t)MROWS * 1280 : temp + 1024);
            const int lda = (L == 1) ? 6144 : (L == 2 ? 1024 : 3328);
            pg8::Gemm g{A, Bt, Mh, 1024, K, lda};
            pg8::StaticOrder S; S.init(Mh, 1024, G, (int)blockIdx.x);
            pg8::EpiRes E{xb, ssq + (size_t)(3 * L + 2) * 4 * MROWS, (L == 2) ? ARGP(35) : nullptr, 1.0f, row0, (LAS float*)(lds + 131072), tid};
            pg8::gemm_phase<pg8::EpiRes, pg8::StaticOrder, true, true>(lds, g, S, E, tid);
        } else if (kind == 5) { gla_core(lds, temp, (const GAS bf16_t*)(ws + WS_KST), (const GAS float*)(ws + WS_DEC), (const GAS bf16_t*)(ws + WS_PBUF), (GAS bf16_t*)outp, tid); }
        else if (kind == 12) { gla_pre(lds, temp, (GAS bf16_t*)(ws + WS_KST), (GAS float*)(ws + WS_DEC), (GAS bf16_t*)(ws + WS_PBUF), ARGP(base + 5), ARGP(base + 6), tid); }
        else if (kind == 6) { gla_post(temp, (const GAS bf16_t*)outp, ARGP(base + 7), tid); }
        else if (kind == 7) { sgu_spatial(lds, temp, lnstat, hf * (MROWS / 2), ARGP(19), ARGP(20), ARGP(21), ARGP(22), tid); }
        else if (kind == 8) { swa_attn(lds, temp, temp + (size_t)MROWS * 1280, (const GAS float*)(ws + WS_ROPE), ARGP(33), tid); }
        else { final_norm(xb, outp, ssq + (size_t)12 * 4 * MROWS, ARGP(51), tid); }
        if (G == 0x7fffffff) {
            grid.sync();
        } else if (op + 1 < NOPS) { XcdBarrier xbar; xbar.bar = (unsigned*)((unsigned char*)kp[53] + WS_BAR); xbar.x = xb_xcc_id(); xbar.st = (volatile LAS unsigned*)(lds + LDS_BYTES - 16); xcd_barrier(xbar); }
    }
}

extern "C" void kernel_launch(void* const* d_in, const int* in_sizes, int n_in, void* d_out, int out_size, void* d_ws, size_t ws_size, hipStream_t stream) {
    static int grid = 0;
    if (grid == 0) {
        if (n_in != 52 || out_size != MROWS * DM || ws_size < WS_END2) { fprintf(stderr, "kernel_launch: unexpected shapes: n_in %d out %d ws %zu (need %zu)\n", n_in, out_size, ws_size, (size_t)WS_END2); grid = -1; return; }
        int dev = 0, cus = 0, per_cu = 0;
        hipGetDevice(&dev); hipDeviceGetAttribute(&cus, hipDeviceAttributeMultiprocessorCount, dev);
        if (hipFuncSetAttribute((const void*)mega_fwd, hipFuncAttributeMaxDynamicSharedMemorySize, LDS_BYTES) != hipSuccess) { fprintf(stderr, "kernel_launch: hipFuncSetAttribute failed\n"); grid = -1; return; }
        if (hipOccupancyMaxActiveBlocksPerMultiprocessor(&per_cu, (const void*)mega_fwd, 512, LDS_BYTES) != hipSuccess || per_cu < 1) { fprintf(stderr, "kernel_launch: occupancy query says %d\n", per_cu); per_cu = 1; }
        (void)hipGetLastError();
        grid = cus;
    }
    if (grid < 0) return;
    if (hipMemsetAsync((char*)d_ws + WS_BAR, 0, WS_BAR_BYTES, stream) != hipSuccess) { fprintf(stderr, "kernel_launch: memset of barrier words failed\n"); return; }
    Args a{};
    for (int i = 0; i < 52; ++i) a.in[i] = (const float*)d_in[i];
    a.out = (float*)d_out; a.ws = (unsigned char*)d_ws;
    void* args[] = {&a};
    hipError_t e = hipLaunchCooperativeKernel((const void*)mega_fwd, dim3(grid), dim3(512), args, LDS_BYTES, stream);
    if (e != hipSuccess) fprintf(stderr, "kernel_launch: cooperative launch failed: %s (grid %d)\n", hipGetErrorString(e), grid);
}
```

```cpp
#include <hip/hip_runtime.h>
#include <hip/hip_cooperative_groups.h>
#include <cstdio>
#include <cstdint>
#include <cmath>
namespace cg = cooperative_groups;
namespace pg8 {
#define PG8_LAS __attribute__((address_space(3)))
#define GAS __attribute__((address_space(1)))
typedef unsigned short bf16_t;
typedef short bf16x8 __attribute__((ext_vector_type(8)));
typedef float f32x4 __attribute__((ext_vector_type(4)));
typedef unsigned u32x4 __attribute__((ext_vector_type(4)));
constexpr int BM = 256, BK = 64, HALF = 128, HTB = HALF * BK * 2  , STAGE_BYTES = 8 * HTB, NXCD = 8, WGM = 8;

__host__ __device__ __forceinline__ int lds_byte(int r, int c) { const int st = (r >> 4) * 2 + (c >> 5), rr = r & 15, cc = c & 31, ob = rr * 64 + cc * 2; return st * 1024 + (ob ^ (((ob >> 9) & 1) << 5)); }
__host__ __device__ __forceinline__ void stage_rc(int b, int& R, int& C) { const int st = b / 1024, sb = b % 1024, swz = sb ^ (((sb >> 9) & 1) << 5); R = (st >> 1) * 16 + swz / 64; C = (st & 1) * 32 + (swz % 64) / 2; }
__host__ __device__ __forceinline__ int perm32(int rho) { const int n = rho >> 4, i = rho & 15; return 8 * (i >> 2) + 4 * n + (i & 3); }

struct Unit { int pm, pn; };
struct Gemm { const GAS bf16_t* A; const GAS bf16_t* Bt; int M, N, K, lda; };

struct StaticOrder {
    int nM, nN, nwg, G, c;
    __host__ __device__ void init(int M, int N, int G_, int c_) { nM = M / BM; nN = N / BM; nwg = nM * nN; G = G_; c = c_; }
    __host__ __device__ bool next(int i, Unit& u) const {
        const long L = (long)i * G + c; if (L >= nwg) return false;
        int wgid = (int)L; { const int q = nwg / NXCD, r = nwg % NXCD, xcd = wgid % NXCD, off = wgid / NXCD; wgid = (xcd < r ? xcd * (q + 1) : r * (q + 1) + (xcd - r) * q) + off; }
        const int nig = WGM * nN, gid = wgid / nig, fm = gid * WGM, gsz = (nM - fm) < WGM ? (nM - fm) : WGM;
        u.pm = fm + ((wgid % nig) % gsz); u.pn = (wgid % nig) / gsz; return true;
    }
    __device__ __forceinline__ void a_ready(const Unit&) const {}
    __device__ __forceinline__ void done(const Unit&) const {}
};


typedef __bf16 bf16v2_t __attribute__((ext_vector_type(2)));
__device__ __forceinline__ unsigned cvt_pk_bf16(float lo, float hi) { bf16v2_t v; v.x = (__bf16)lo; v.y = (__bf16)hi; return __builtin_bit_cast(unsigned, v); }
typedef float f32x2 __attribute__((ext_vector_type(2)));
__device__ __forceinline__ f32x2 gelu_pk(f32x2 v) {
    const f32x2 av = __builtin_elementwise_abs(v), d = av * 0.2316418882f + 1.0f;
    f32x2 t; t.x = __builtin_amdgcn_rcpf(d.x); t.y = __builtin_amdgcn_rcpf(d.y);
    f32x2 q = t * 0.5307027145f + (-0.7265760135f); q = q * t + 0.7107068705f; q = q * t + (-0.142248368f); q = q * t + 0.127414796f; q = q * t;
    const f32x2 s = (v * v) * (-0.72134752044f);
    f32x2 e; e.x = __builtin_amdgcn_exp2f(s.x); e.y = __builtin_amdgcn_exp2f(s.y);
    const f32x2 m = v * (q * e), r = v - m;
    f32x2 o; o.x = v.x < 0.f ? m.x : r.x; o.y = v.y < 0.f ? m.y : r.y; return o;
}
__device__ __forceinline__ float silu_f(float g) { return g * __builtin_amdgcn_rcpf(1.0f + __expf(-g)); }
constexpr float RMS_EPS = 1e-5f;
constexpr int SSQ_M = 32768;
__device__ __forceinline__ float ssq4(const GAS float* p, int r) { const f32x4 v = *(const GAS f32x4*)(p + 4 * (size_t)r); return (v[0] + v[1]) + (v[2] + v[3]); }

struct EpiSwiGLU {
    static constexpr bool PERM = true, AFTER_DRAIN = false;
    GAS bf16_t* H; int ldh; const GAS float* ssq;
    PG8_LAS f32x4* slot;
    __device__ __forceinline__ void prime(const Unit& u, int wr, int fr) {
        float t[2][4];
#pragma unroll
        for (int ai = 0; ai < 2; ++ai)
#pragma unroll
            for (int m = 0; m < 4; ++m) t[ai][m] = ssq4(ssq, u.pm * BM + wr * 64 + fr + ai * HALF + m * 16);
        slot[0] = (f32x4){t[0][0], t[0][1], t[0][2], t[0][3]}; slot[1] = (f32x4){t[1][0], t[1][1], t[1][2], t[1][3]};
    }
    __device__ __forceinline__ void operator()(const f32x4 (&acc)[2][2][4][2], const Unit& u, const Unit& nx, int wr, int wc, int fr, int fq) {
        const int row0 = u.pm * BM + wr * 64 + fr, col0 = u.pn * HALF + wc * 32 + 8 * fq;
        const f32x4 sa = slot[0], sb = slot[1]; const float rsv[2][4] = {{sa[0], sa[1], sa[2], sa[3]}, {sb[0], sb[1], sb[2], sb[3]}};
        f32x4 nv[2][4];
#pragma unroll
        for (int ai = 0; ai < 2; ++ai)
#pragma unroll
            for (int m = 0; m < 4; ++m) nv[ai][m] = *(const GAS f32x4*)(ssq + 4 * (size_t)(nx.pm * BM + wr * 64 + fr + ai * HALF + m * 16));
#pragma unroll
        for (int ai = 0; ai < 2; ++ai)
#pragma unroll
            for (int m = 0; m < 4; ++m) {
                const int r = row0 + ai * HALF + m * 16;
                const float rs = __builtin_amdgcn_rsqf(rsv[ai][m] * (1.0f / 1024.0f) + RMS_EPS);
                const float c1 = rs * -1.4426950408889634f, rs2 = rs * rs;
                const f32x4 g0 = acc[ai][0][m][0], g1 = acc[ai][0][m][1];
                f32x4 z0 = g0 * c1, z1 = g1 * c1;
                const f32x4 t0 = (g0 * acc[ai][1][m][0]) * rs2, t1 = (g1 * acc[ai][1][m][1]) * rs2;
#pragma unroll
                for (int k = 0; k < 4; ++k) { z0[k] = __builtin_amdgcn_exp2f(z0[k]); z1[k] = __builtin_amdgcn_exp2f(z1[k]); }
                z0 = z0 + 1.0f; z1 = z1 + 1.0f;
#pragma unroll
                for (int k = 0; k < 4; ++k) { z0[k] = __builtin_amdgcn_rcpf(z0[k]); z1[k] = __builtin_amdgcn_rcpf(z1[k]); }
                const f32x4 h0 = t0 * z0, h1 = t1 * z1;
                float hv[8] = {h0[0], h0[1], h0[2], h0[3], h1[0], h1[1], h1[2], h1[3]};
                u32x4 w; w.x = cvt_pk_bf16(hv[0], hv[1]); w.y = cvt_pk_bf16(hv[2], hv[3]); w.z = cvt_pk_bf16(hv[4], hv[5]); w.w = cvt_pk_bf16(hv[6], hv[7]);
                *(GAS u32x4*)(H + (size_t)r * ldh + col0) = w;
            }
        { float t[2][4];
#pragma unroll
          for (int ai = 0; ai < 2; ++ai)
#pragma unroll
            for (int m = 0; m < 4; ++m) t[ai][m] = (nv[ai][m][0] + nv[ai][m][1]) + (nv[ai][m][2] + nv[ai][m][3]);
          slot[0] = (f32x4){t[0][0], t[0][1], t[0][2], t[0][3]}; slot[1] = (f32x4){t[1][0], t[1][1], t[1][2], t[1][3]}; }
    }
};
__device__ __forceinline__ float bf_lo(unsigned w) { return __builtin_bit_cast(float, w << 16); }
__device__ __forceinline__ float bf_hi(unsigned w) { return __builtin_bit_cast(float, w & 0xffff0000u); }
struct EpiRes {
    static constexpr bool PERM = true, AFTER_DRAIN = false;
    GAS bf16_t* xb; GAS float* ssq_out; const GAS float* bias; float alpha; int row0; PG8_LAS float* red; int tid;
    __device__ __forceinline__ void prime(const Unit&, int, int) {}
    __device__ __forceinline__ void operator()(const f32x4 (&acc)[2][2][4][2], const Unit& u, const Unit&, int wr, int wc, int fr, int fq) {
        const int rowb = row0 + u.pm * BM + wr * 64 + fr, col0 = u.pn * BM + wc * 32 + 8 * fq;
        f32x4 bv[2][2];
#pragma unroll
        for (int bj = 0; bj < 2; ++bj)
#pragma unroll
            for (int n = 0; n < 2; ++n) bv[bj][n] = bias ? *(const GAS f32x4*)(bias + col0 + bj * HALF + 4 * n) : (f32x4){0.f, 0.f, 0.f, 0.f};
#pragma unroll
        for (int ai = 0; ai < 2; ++ai) {
            u32x4 xov[4][2];
#pragma unroll
            for (int m = 0; m < 4; ++m)
#pragma unroll
                for (int bj = 0; bj < 2; ++bj) xov[m][bj] = *(const GAS u32x4*)(xb + (size_t)(rowb + ai * HALF + m * 16) * 1024 + col0 + bj * HALF);
#pragma unroll
            for (int m = 0; m < 4; ++m) {
                const int r = rowb + ai * HALF + m * 16; const size_t off = (size_t)r * 1024 + col0; float s = 0.f;
#pragma unroll
                for (int bj = 0; bj < 2; ++bj) {
                    const u32x4 xo = xov[m][bj];
                    const f32x4 o0 = (f32x4){bf_lo(xo.x), bf_hi(xo.x), bf_lo(xo.y), bf_hi(xo.y)}, o1 = (f32x4){bf_lo(xo.z), bf_hi(xo.z), bf_lo(xo.w), bf_hi(xo.w)};
                    const f32x4 v0 = o0 + (acc[ai][bj][m][0] + bv[bj][0]) * alpha, v1 = o1 + (acc[ai][bj][m][1] + bv[bj][1]) * alpha;
                    u32x4 w; w.x = cvt_pk_bf16(v0[0], v0[1]); w.y = cvt_pk_bf16(v0[2], v0[3]); w.z = cvt_pk_bf16(v1[0], v1[1]); w.w = cvt_pk_bf16(v1[2], v1[3]);
                    *(GAS u32x4*)(xb + off + bj * HALF) = w;
                    s += (v0[0] * v0[0] + v0[1] * v0[1]) + (v0[2] * v0[2] + v0[3] * v0[3]) + (v1[0] * v1[0] + v1[1] * v1[1]) + (v1[2] * v1[2] + v1[3] * v1[3]);
                }
                s += __shfl_xor(s, 16); s += __shfl_xor(s, 32);
                if (fq == 0) red[(ai * HALF + wr * 64 + m * 16 + fr) * 4 + wc] = s;
            }
        }
        asm volatile("s_waitcnt lgkmcnt(0)" ::: "memory"); __builtin_amdgcn_s_barrier(); asm volatile("" ::: "memory");
        if (tid < 256) { const f32x4 v = *(const PG8_LAS f32x4*)(red + tid * 4); ssq_out[4 * (size_t)(row0 + u.pm * BM + tid) + u.pn] = (v[0] + v[1]) + (v[2] + v[3]); }
    }
};
struct EpiPlain {
    static constexpr bool PERM = true, AFTER_DRAIN = false;
    GAS bf16_t* O; int ldo; const GAS float* ssq; const GAS float* bias; int act; GAS float* lnstat; int stat_pn0; int row0; PG8_LAS float* red; int tid;
    PG8_LAS f32x4* slot;
    __device__ __forceinline__ void prime(const Unit& u, int wr, int fr) {
        float t[2][4];
#pragma unroll
        for (int ai = 0; ai < 2; ++ai)
#pragma unroll
            for (int m = 0; m < 4; ++m) t[ai][m] = ssq4(ssq, row0 + u.pm * BM + wr * 64 + fr + ai * HALF + m * 16);
        slot[0] = (f32x4){t[0][0], t[0][1], t[0][2], t[0][3]}; slot[1] = (f32x4){t[1][0], t[1][1], t[1][2], t[1][3]};
    }
    __device__ __forceinline__ void operator()(const f32x4 (&acc)[2][2][4][2], const Unit& u, const Unit& nx, int wr, int wc, int fr, int fq) {
        const int rowl = u.pm * BM + wr * 64 + fr, col0 = u.pn * BM + wc * 32 + 8 * fq;
        const bool dostat = (lnstat != nullptr) && (u.pn >= stat_pn0);
        const f32x4 sa = slot[0], sb = slot[1]; const float rsv[2][4] = {{sa[0], sa[1], sa[2], sa[3]}, {sb[0], sb[1], sb[2], sb[3]}};
        f32x4 nv[2][4];
#pragma unroll
        for (int ai = 0; ai < 2; ++ai)
#pragma unroll
            for (int m = 0; m < 4; ++m) nv[ai][m] = *(const GAS f32x4*)(ssq + 4 * (size_t)(row0 + nx.pm * BM + wr * 64 + fr + ai * HALF + m * 16));
        f32x4 bv[2][2];
#pragma unroll
        for (int bj = 0; bj < 2; ++bj)
#pragma unroll
            for (int n = 0; n < 2; ++n) bv[bj][n] = bias ? *(const GAS f32x4*)(bias + col0 + bj * HALF + 4 * n) : (f32x4){0.f, 0.f, 0.f, 0.f};
#pragma unroll
        for (int ai = 0; ai < 2; ++ai)
#pragma unroll
            for (int m = 0; m < 4; ++m) {
                const int rl = rowl + ai * HALF + m * 16, rg = row0 + rl;
                const float rs = __builtin_amdgcn_rsqf(rsv[ai][m] * (1.0f / 1024.0f) + RMS_EPS);
                float s1 = 0.f, s2 = 0.f;
#pragma unroll
                for (int bj = 0; bj < 2; ++bj) {
                    f32x4 v0 = acc[ai][bj][m][0] * rs + bv[bj][0], v1 = acc[ai][bj][m][1] * rs + bv[bj][1];
                    if (act) { const f32x2 a = gelu_pk((f32x2){v0[0], v0[1]}), b = gelu_pk((f32x2){v0[2], v0[3]}), c = gelu_pk((f32x2){v1[0], v1[1]}), d = gelu_pk((f32x2){v1[2], v1[3]});
                        v0 = (f32x4){a.x, a.y, b.x, b.y}; v1 = (f32x4){c.x, c.y, d.x, d.y}; }
                    u32x4 w; w.x = cvt_pk_bf16(v0[0], v0[1]); w.y = cvt_pk_bf16(v0[2], v0[3]); w.z = cvt_pk_bf16(v1[0], v1[1]); w.w = cvt_pk_bf16(v1[2], v1[3]);
                    *(GAS u32x4*)(O + (size_t)rl * ldo + col0 + bj * HALF) = w;
                    s1 += (v0[0] + v0[1]) + (v0[2] + v0[3]) + (v1[0] + v1[1]) + (v1[2] + v1[3]);
                    s2 += (v0[0] * v0[0] + v0[1] * v0[1]) + (v0[2] * v0[2] + v0[3] * v0[3]) + (v1[0] * v1[0] + v1[1] * v1[1]) + (v1[2] * v1[2] + v1[3] * v1[3]);
                }
                if (dostat) {
                    s1 += __shfl_xor(s1, 16); s1 += __shfl_xor(s1, 32); s2 += __shfl_xor(s2, 16); s2 += __shfl_xor(s2, 32);
                    if (fq == 0) { red[(rl - u.pm * BM) * 4 + wc] = s1; red[1024 + (rl - u.pm * BM) * 4 + wc] = s2; }
                }
            }
        { float t[2][4];
#pragma unroll
          for (int ai = 0; ai < 2; ++ai)
#pragma unroll
            for (int m = 0; m < 4; ++m) t[ai][m] = (nv[ai][m][0] + nv[ai][m][1]) + (nv[ai][m][2] + nv[ai][m][3]);
          slot[0] = (f32x4){t[0][0], t[0][1], t[0][2], t[0][3]}; slot[1] = (f32x4){t[1][0], t[1][1], t[1][2], t[1][3]}; }
        if (dostat) {
            asm volatile("s_waitcnt lgkmcnt(0)" ::: "memory"); __builtin_amdgcn_s_barrier(); asm volatile("" ::: "memory");
            if (tid < 256) { const f32x4 a = *(const PG8_LAS f32x4*)(red + tid * 4), b = *(const PG8_LAS f32x4*)(red + 1024 + tid * 4);
                f32x2 o; o.x = (a[0] + a[1]) + (a[2] + a[3]); o.y = (b[0] + b[1]) + (b[2] + b[3]);
                *(GAS f32x2*)(lnstat + 24 * (size_t)(row0 + u.pm * BM + tid) + 2 * (u.pn - stat_pn0)) = o; }
        }
    }
};

template <class Epi, class Sched, bool ALIGN_EPI = false, bool SP2 = false>
__device__ __forceinline__ void gemm_phase(PG8_LAS unsigned char* lds, const Gemm g, const Sched& S, Epi& E, const int tid) {
    const int wid = __builtin_amdgcn_readfirstlane(tid >> 6), lane = tid & 63, wr = wid >> 2, wc = wid & 3, fr = lane & 15, fq = lane >> 4;
    const int K = g.K, nt = K / BK;
    unsigned voffA[2], voffB[2];
#pragma unroll
    for (int i = 0; i < 2; ++i) { int R, C; stage_rc(tid * 16 + i * 8192, R, C); const int Rb = Epi::PERM ? ((R & ~31) + perm32(R & 31)) : R;
        voffA[i] = (unsigned)(R * g.lda + C) * 2u; voffB[i] = (unsigned)(Rb * K + C) * 2u; }
    const size_t kstep = (size_t)(BK * 2);
    const size_t hstepA = (size_t)HALF * g.lda * 2, hstepB = (size_t)HALF * K * 2;
    const size_t tstepA = 2 * hstepA, tstepB = 2 * hstepB;
    const unsigned ldsw = (unsigned)wid * 1024u;
    const int aoff = lds_byte(wr * 64 + fr, fq * 8), boff = lds_byte(wc * 32 + fr, fq * 8);
#define PG8_SA(b, h) (((b) * 2 + (h)) * HTB)
#define PG8_SB(b, h) ((4 + (b) * 2 + (h)) * HTB)
#define PG8_STAGE(bufoff, gbase, voff) do { _Pragma("unroll") for (int _i = 0; _i < 2; ++_i) \
        __builtin_amdgcn_global_load_lds((const GAS unsigned*)((const GAS char*)(gbase) + (voff)[_i]), (PG8_LAS unsigned*)(lds + (bufoff) + ldsw + _i * 8192), 16, 0, 0); } while (0)
#define PG8_LDA(dst, b, h) do { _Pragma("unroll") for (int m = 0; m < 4; ++m) _Pragma("unroll") for (int k = 0; k < 2; ++k) dst[m][k] = *(const PG8_LAS bf16x8*)(lds + PG8_SA(b, h) + aoff + m * 2048 + k * 1024); } while (0)
#define PG8_LDB(dst, b, h) do { _Pragma("unroll") for (int n = 0; n < 2; ++n) _Pragma("unroll") for (int k = 0; k < 2; ++k) dst[n][k] = *(const PG8_LAS bf16x8*)(lds + PG8_SB(b, h) + boff + n * 2048 + k * 1024); } while (0)
#define PG8_MMA(ai, bj, At, Bt) do { __builtin_amdgcn_s_setprio(1); _Pragma("unroll") for (int m = 0; m < 4; ++m) _Pragma("unroll") for (int n = 0; n < 2; ++n) _Pragma("unroll") for (int k = 0; k < 2; ++k) \
        acc[ai][bj][m][n] = __builtin_amdgcn_mfma_f32_16x16x32_bf16(Bt[n][k], At[m][k], acc[ai][bj][m][n], 0, 0, 0); __builtin_amdgcn_s_setprio(0); } while (0)
#define PG8_WAIT_V(n) asm volatile("s_waitcnt vmcnt(" #n ")" ::: "memory")
#define PG8_WAIT_L(n) asm volatile("s_waitcnt lgkmcnt(" #n ")" ::: "memory")
#define PG8_BAR __builtin_amdgcn_s_barrier()
#define PG8_SCHED __builtin_amdgcn_sched_barrier(0)
    Unit cur, nxt; int ui = 0;
    if (!S.next(0, cur)) return;
    f32x4 acc[2][2][4][2];
#pragma unroll
    for (int a = 0; a < 2; ++a)
#pragma unroll
        for (int b = 0; b < 2; ++b)
#pragma unroll
            for (int m = 0; m < 4; ++m)
#pragma unroll
                for (int n = 0; n < 2; ++n) acc[a][b][m][n] = (f32x4){0.f, 0.f, 0.f, 0.f};
    bf16x8 At[4][2], B0[2][2], B1[2][2];
    const GAS char* cA = (const GAS char*)g.A + (size_t)cur.pm * tstepA; const GAS char* cB = (const GAS char*)g.Bt + (size_t)cur.pn * tstepB;
    S.a_ready(cur);
    E.prime(cur, wr, fr);
    if constexpr (SP2) {
        PG8_STAGE(PG8_SB(0, 0), cB, voffB); PG8_STAGE(PG8_SB(0, 1), cB + hstepB, voffB); PG8_STAGE(PG8_SA(0, 0), cA, voffA); PG8_STAGE(PG8_SA(0, 1), cA + hstepA, voffA);
        if (wr == 1) PG8_BAR;
        PG8_WAIT_V(2); PG8_BAR;
        PG8_STAGE(PG8_SB(1, 0), cB + kstep, voffB); PG8_STAGE(PG8_SA(1, 0), cA + kstep, voffA); PG8_STAGE(PG8_SB(1, 1), cB + hstepB + kstep, voffB);
        PG8_WAIT_V(6); PG8_BAR;
    } else {
        PG8_STAGE(PG8_SB(0, 0), cB, voffB); PG8_STAGE(PG8_SA(0, 0), cA, voffA); PG8_STAGE(PG8_SB(0, 1), cB + hstepB, voffB); PG8_STAGE(PG8_SA(0, 1), cA + hstepA, voffA);
        if (wr == 1) PG8_BAR;
        PG8_WAIT_V(4); PG8_BAR;
        PG8_STAGE(PG8_SB(1, 0), cB + kstep, voffB); PG8_STAGE(PG8_SA(1, 0), cA + kstep, voffA); PG8_STAGE(PG8_SB(1, 1), cB + hstepB + kstep, voffB);
        PG8_WAIT_V(6); PG8_BAR;
    }
    for (;;) {
        const bool has_next = S.next(ui + 1, nxt);
        const GAS char* nA = has_next ? (const GAS char*)g.A + (size_t)nxt.pm * tstepA : cA; const GAS char* nB = has_next ? (const GAS char*)g.Bt + (size_t)nxt.pn * tstepB : cB;
        for (int t = 0; t < nt; t += 2) {
            const bool last = (t == nt - 2);
            const GAS char* a1 = cA + (size_t)(t + 1) * kstep;
            const GAS char* a2 = last ? nA : cA + (size_t)(t + 2) * kstep; const GAS char* b2 = last ? nB : cB + (size_t)(t + 2) * kstep;
            const GAS char* a3 = a2 + kstep; const GAS char* b3 = b2 + kstep;
            if (last && has_next) S.a_ready(nxt);
            if constexpr (SP2) {
            PG8_LDB(B0, 0, 0); PG8_LDB(B1, 0, 1); PG8_SCHED; PG8_LDA(At, 0, 0); PG8_STAGE(PG8_SA(1, 1), a1 + hstepA, voffA);
            PG8_WAIT_V(8); PG8_WAIT_L(0); PG8_BAR; PG8_MMA(0, 0, At, B0); PG8_MMA(0, 1, At, B1); PG8_BAR; PG8_SCHED;
            PG8_LDA(At, 0, 1); PG8_STAGE(PG8_SB(0, 0), b2, voffB); PG8_STAGE(PG8_SB(0, 1), b2 + hstepB, voffB); PG8_STAGE(PG8_SA(0, 0), a2, voffA);
            PG8_WAIT_V(8); PG8_WAIT_L(0); PG8_BAR; PG8_MMA(1, 0, At, B0); PG8_MMA(1, 1, At, B1); PG8_BAR; PG8_SCHED;
            PG8_LDB(B0, 1, 0); PG8_LDB(B1, 1, 1); PG8_SCHED; PG8_LDA(At, 1, 0); PG8_STAGE(PG8_SA(0, 1), a2 + hstepA, voffA);
            PG8_WAIT_V(8); PG8_WAIT_L(0); PG8_BAR; PG8_MMA(0, 0, At, B0); PG8_MMA(0, 1, At, B1); PG8_BAR; PG8_SCHED;
            PG8_LDA(At, 1, 1); PG8_STAGE(PG8_SB(1, 0), b3, voffB); PG8_STAGE(PG8_SB(1, 1), b3 + hstepB, voffB); PG8_STAGE(PG8_SA(1, 0), a3, voffA);
            PG8_WAIT_V(8); PG8_WAIT_L(0); PG8_BAR; PG8_MMA(1, 0, At, B0); PG8_MMA(1, 1, At, B1); PG8_BAR; PG8_SCHED;
            } else {
            PG8_LDB(B0, 0, 0); PG8_SCHED; PG8_LDA(At, 0, 0); PG8_STAGE(PG8_SA(1, 1), a1 + hstepA, voffA);
            PG8_WAIT_L(8); PG8_BAR; PG8_WAIT_L(0); PG8_MMA(0, 0, At, B0); PG8_BAR; PG8_SCHED;
            PG8_LDB(B1, 0, 1); PG8_STAGE(PG8_SB(0, 0), b2, voffB);
            PG8_BAR; PG8_WAIT_L(0); PG8_MMA(0, 1, At, B1); PG8_BAR;
            PG8_LDA(At, 0, 1); PG8_STAGE(PG8_SA(0, 0), a2, voffA);
            PG8_BAR; PG8_WAIT_L(0); PG8_MMA(1, 0, At, B0); PG8_BAR; PG8_SCHED;
            PG8_STAGE(PG8_SB(0, 1), b2 + hstepB, voffB);
            PG8_WAIT_V(6); PG8_BAR; PG8_MMA(1, 1, At, B1); PG8_BAR;
            PG8_LDB(B0, 1, 0); PG8_SCHED; PG8_LDA(At, 1, 0); PG8_STAGE(PG8_SA(0, 1), a2 + hstepA, voffA);
            PG8_WAIT_L(8); PG8_BAR; PG8_WAIT_L(0); PG8_MMA(0, 0, At, B0); PG8_BAR; PG8_SCHED;
            PG8_LDB(B1, 1, 1); PG8_STAGE(PG8_SB(1, 0), b3, voffB);
            PG8_BAR; PG8_WAIT_L(0); PG8_MMA(0, 1, At, B1); PG8_BAR;
            PG8_LDA(At, 1, 1); PG8_STAGE(PG8_SA(1, 0), a3, voffA);
            PG8_BAR; PG8_WAIT_L(0); PG8_MMA(1, 0, At, B0); PG8_BAR; PG8_SCHED;
            PG8_STAGE(PG8_SB(1, 1), b3 + hstepB, voffB);
            PG8_WAIT_V(6); PG8_BAR; PG8_MMA(1, 1, At, B1); PG8_BAR;
            }
        }
        if constexpr (ALIGN_EPI) { if (wr == 0) PG8_BAR; }
        if constexpr (!Epi::AFTER_DRAIN) { E(acc, cur, has_next ? nxt : cur, wr, wc, fr, fq); S.done(cur); }
        if (!has_next) break;
#pragma unroll
        for (int a = 0; a < 2; ++a)
#pragma unroll
            for (int b = 0; b < 2; ++b)
#pragma unroll
                for (int m = 0; m < 4; ++m)
#pragma unroll
                    for (int n = 0; n < 2; ++n) acc[a][b][m][n] = (f32x4){0.f, 0.f, 0.f, 0.f};
        cur = nxt; cA = nA; cB = nB; ++ui;
        if constexpr (ALIGN_EPI) { if (wr == 1) PG8_BAR; }
    }
    PG8_WAIT_V(0);
    if constexpr (!ALIGN_EPI) { if (wr == 0) PG8_BAR; }
    PG8_BAR;
    if constexpr (Epi::AFTER_DRAIN) { E.fused(acc, cur, wr, wc, fr, fq, lds, wid, lane); S.done(cur); }
#undef PG8_SA
#undef PG8_SB
#undef PG8_STAGE
#undef PG8_LDA
#undef PG8_LDB
#undef PG8_MMA
#undef PG8_WAIT_V
#undef PG8_WAIT_L
#undef PG8_BAR
#undef PG8_SCHED
}
}

#define LAS __attribute__((address_space(3)))
typedef pg8::bf16_t bf16_t;
typedef pg8::bf16x8 bf16x8;
typedef pg8::f32x4 f32x4;
typedef pg8::u32x4 u32x4;
typedef unsigned u32x2 __attribute__((ext_vector_type(2)));
using pg8::cvt_pk_bf16;

constexpr int DM = 1024, SEQL = 4096, NBATCH = 8, MROWS = NBATCH * SEQL, DFF = 2816;
constexpr int LDS_BYTES = 155712;
constexpr size_t SZ_FFN_IN = (size_t)5632 * 1024 * 2, SZ_FFN_OUT = (size_t)1024 * 2816 * 2, SZ_FFN = SZ_FFN_IN + SZ_FFN_OUT;
constexpr size_t SZ_GLA_IN = (size_t)3328 * 1024 * 2, SZ_GLA_OUT = (size_t)1024 * 1024 * 2, SZ_GLA = SZ_GLA_IN + SZ_GLA_OUT;
constexpr size_t SZ_SGU_IN = (size_t)6144 * 1024 * 2, SZ_SGU_OUT = (size_t)1024 * 3072 * 2;
constexpr size_t SZ_SWA_IN = (size_t)1280 * 1024 * 2, SZ_SWA_OUT = (size_t)1024 * 1024 * 2;
constexpr size_t WS_FFN = 0;
constexpr size_t WS_GLA = WS_FFN + 8 * SZ_FFN;
constexpr size_t WS_SGU = WS_GLA + 2 * SZ_GLA;
constexpr size_t WS_SWA = WS_SGU + SZ_SGU_IN + SZ_SGU_OUT;
constexpr size_t WS_XB = WS_SWA + SZ_SWA_IN + SZ_SWA_OUT;
constexpr size_t WS_TEMP = WS_XB + (size_t)MROWS * 1024 * 2;
constexpr size_t SZ_TEMP = (size_t)MROWS * 3328 * 2;
constexpr size_t WS_SSQ = WS_TEMP + SZ_TEMP;
constexpr size_t WS_LNSTAT = WS_SSQ + 13 * 4 * (size_t)MROWS * 4;
constexpr size_t WS_ROPE = WS_LNSTAT + (size_t)MROWS * 24 * 4;
constexpr size_t WS_DEC = WS_ROPE + (size_t)MROWS * 16 * 4;
constexpr size_t WS_END = WS_DEC + 16 * (size_t)MROWS * 4 * 4;
constexpr size_t WS_BAR = WS_END, WS_BAR_BYTES = 16384, WS_KST = WS_BAR + WS_BAR_BYTES, WS_PBUF = WS_KST + (size_t)2048 * 8192 * 2, WS_END2 = WS_PBUF + (size_t)2048 * 4096 * 2;
static_assert(WS_END2 <= (size_t)512 * 1024 * 1024, "workspace map");

struct Args { const float* in[52]; float* out; unsigned char* ws; };

__device__ __forceinline__ float bf2f(unsigned v) { return __builtin_bit_cast(float, v << 16); }
__device__ __forceinline__ float bflo(unsigned w) { return __builtin_bit_cast(float, w << 16); }
__device__ __forceinline__ float bfhi(unsigned w) { return __builtin_bit_cast(float, w & 0xffff0000u); }
__device__ __forceinline__ bf16_t f2bf(float f) { return __builtin_bit_cast(bf16_t, (__bf16)f); }
__device__ __forceinline__ f32x4 mfma16(bf16x8 a, bf16x8 b, f32x4 c) { return __builtin_amdgcn_mfma_f32_16x16x32_bf16(a, b, c, 0, 0, 0); }
__device__ __forceinline__ float wave_sum(float v) {
#pragma unroll
    for (int o = 1; o < 64; o <<= 1) v += __shfl_xor(v, o);
    return v;
}
__device__ __forceinline__ int layer_base(int L) { return L == 0 ? 2 : (L == 1 ? 14 : (L == 2 ? 27 : 39)); }
__device__ __forceinline__ GAS unsigned char* mixer_w(GAS unsigned char* ws, int L) { return ws + (L == 0 ? WS_GLA : (L == 3 ? WS_GLA + SZ_GLA : (L == 1 ? WS_SGU : WS_SWA))); }
__device__ __forceinline__ size_t mixer_in_sz(int L) { return L == 1 ? SZ_SGU_IN : (L == 2 ? SZ_SWA_IN : SZ_GLA_IN); }

typedef const __attribute__((address_space(4))) unsigned long long* KPTR;
#define ARGP(i) ((const GAS float*)kp[i])
struct MatDesc { const GAS float* src; const GAS float* gain; GAS bf16_t* dst; int K, N, mode; };
__device__ __forceinline__ MatDesc get_mat(KPTR kp, GAS unsigned char* ws, int mat) {
    const int L = mat / 6, j = mat % 6, base = layer_base(L), f2 = base + (L == 1 ? 10 : 9);
    MatDesc d;
    if (j == 0)      { d.src = ARGP(base + 1); d.gain = ARGP(base); d.dst = (GAS bf16_t*)(ws + WS_FFN + (size_t)(L * 2) * SZ_FFN); d.K = 1024; d.N = 5632; d.mode = 1; }
    else if (j == 1) { d.src = ARGP(base + 2); d.gain = nullptr;    d.dst = (GAS bf16_t*)(ws + WS_FFN + (size_t)(L * 2) * SZ_FFN + SZ_FFN_IN); d.K = 2816; d.N = 1024; d.mode = 0; }
    else if (j == 2) { d.src = ARGP(f2 + 1);   d.gain = ARGP(f2);   d.dst = (GAS bf16_t*)(ws + WS_FFN + (size_t)(L * 2 + 1) * SZ_FFN); d.K = 1024; d.N = 5632; d.mode = 1; }
    else if (j == 3) { d.src = ARGP(f2 + 2);   d.gain = nullptr;    d.dst = (GAS bf16_t*)(ws + WS_FFN + (size_t)(L * 2 + 1) * SZ_FFN + SZ_FFN_IN); d.K = 2816; d.N = 1024; d.mode = 0; }
    else if (j == 4) { d.src = ARGP(base + 4); d.gain = ARGP(base + 3); d.dst = (GAS bf16_t*)mixer_w(ws, L); d.K = 1024; d.N = (L == 1 ? 6144 : (L == 2 ? 1280 : 3088)); d.mode = 0; }
    else             { d.src = ARGP(base + (L == 1 ? 9 : (L == 2 ? 7 : 8))); d.gain = nullptr; d.dst = (GAS bf16_t*)(mixer_w(ws, L) + mixer_in_sz(L)); d.K = (L == 1 ? 3072 : 1024); d.N = 1024; d.mode = 0; }
    return d;
}
__device__ __forceinline__ int mat_items(int mat) {
    const int L = mat / 6, j = mat % 6;
    if (j == 0 || j == 2) return 16 * 88;
    if (j == 1 || j == 3) return 44 * 16;
    if (j == 4) return 16 * (L == 1 ? 96 : (L == 2 ? 20 : 49));
    return (L == 1 ? 48 : 16) * 16;
}
__device__ __forceinline__ void p0_transpose_item(const MatDesc& d, LAS float* scr, int item, int lane) {
    const int nblk = (d.N + 63) / 64, kb = item / nblk, nb = item % nblk, k0 = 64 * kb, n0 = 64 * nb, K = d.K, N = d.N;
    const int c4 = (lane & 15) * 4, r0 = lane >> 4, nn = n0 + c4;
    f32x4 v[16];
#pragma unroll
    for (int i = 0; i < 16; ++i) v[i] = (nn < N) ? *(const GAS f32x4*)(d.src + (size_t)(k0 + r0 + 4 * i) * N + nn) : (f32x4){0.f, 0.f, 0.f, 0.f};
    if (d.gain) {
#pragma unroll
        for (int i = 0; i < 16; ++i) v[i] = v[i] * d.gain[k0 + r0 + 4 * i]; }
#pragma unroll
    for (int i = 0; i < 16; ++i) { LAS float* p = scr + (r0 + 4 * i) * 65 + c4; p[0] = v[i][0]; p[1] = v[i][1]; p[2] = v[i][2]; p[3] = v[i][3]; }
    asm volatile("s_waitcnt lgkmcnt(0)" ::: "memory");
#pragma unroll
    for (int j = 0; j < 8; ++j) { const int id = lane + 64 * j, n = id >> 3, c = id & 7; const LAS float* sp = scr + (8 * c) * 65 + n;
        u32x4 o; o.x = cvt_pk_bf16(sp[0 * 65], sp[1 * 65]); o.y = cvt_pk_bf16(sp[2 * 65], sp[3 * 65]); o.z = cvt_pk_bf16(sp[4 * 65], sp[5 * 65]); o.w = cvt_pk_bf16(sp[6 * 65], sp[7 * 65]);
        const int ng = n0 + n; int row = ng;
        if (d.mode == 1) { row = (ng < 2816) ? ((ng >> 7) * 256 + (ng & 127)) : ((((ng - 2816) >> 7) * 256) + 128 + ((ng - 2816) & 127)); }
        *(GAS u32x4*)(d.dst + (size_t)row * K + k0 + 8 * c) = o; }
    asm volatile("s_waitcnt lgkmcnt(0)" ::: "memory");
}
__device__ __forceinline__ void p0_prologue(KPTR kp, GAS unsigned char* ws_, LAS unsigned char* lds, const int tid) {
    const int lane = tid & 63, wave = tid >> 6, G = gridDim.x;
    const int gw = blockIdx.x * 8 + wave, NGW = G * 8;
    const size_t gt = (size_t)blockIdx.x * 512 + tid, NGT = (size_t)G * 512;
    LAS float* scr = (LAS float*)(lds + wave * 16640);
    int total = 0;
    for (int m = 0; m < 24; ++m) total += mat_items(m);
    for (int it = gw; it < total; it += NGW) {
        int r = it, m = 0;
        for (; m < 23; ++m) { const int c = mat_items(m); if (r < c) break; r -= c; }
        const MatDesc d = get_mat(kp, ws_, m);
        p0_transpose_item(d, scr, r, lane);
    }
    for (size_t i = gt; i < 2 * (size_t)240 * 1024 / 8; i += NGT) { const int which = (int)(i / (240 * 128)); const size_t o = i % (240 * 128);
        *(GAS u32x4*)(ws_ + WS_GLA + (size_t)which * SZ_GLA + (size_t)3088 * 2048 + o * 16) = (u32x4){0u, 0u, 0u, 0u}; }
    { const GAS float* x = ARGP(0); GAS bf16_t* xb = (GAS bf16_t*)(ws_ + WS_XB); GAS float* ssq0 = (GAS float*)(ws_ + WS_SSQ);
      for (int r = gw; r < MROWS; r += NGW) {
        const GAS f32x4* xr = (const GAS f32x4*)(x + (size_t)r * 1024) + lane; float s = 0.f;
        GAS u32x2* o8 = (GAS u32x2*)(xb + (size_t)r * 1024) + lane;
#pragma unroll
        for (int j = 0; j < 4; ++j) { const f32x4 v = xr[64 * j]; s += (v[0] * v[0] + v[1] * v[1]) + (v[2] * v[2] + v[3] * v[3]);
            u32x2 w; w.x = cvt_pk_bf16(v[0], v[1]); w.y = cvt_pk_bf16(v[2], v[3]); o8[64 * j] = w; }
        s = wave_sum(s); if (lane < 4) ssq0[4 * (size_t)r + lane] = (lane == 0) ? s : 0.f; } }
    { const GAS int* pos = (const GAS int*)ARGP(1); GAS float* rope = (GAS float*)(ws_ + WS_ROPE);
      for (size_t i = gt; i < (size_t)MROWS * 8; i += NGT) { const int t = (int)(i >> 3), f = (int)(i & 7);
        const float inv = powf(500000.0f, -(float)f * 0.125f); const float ang = (float)pos[t] * inv;
        rope[(size_t)t * 16 + f] = cosf(ang); rope[(size_t)t * 16 + 8 + f] = sinf(ang); } }
}

__device__ __forceinline__ void gla_pre(LAS unsigned char* lds, GAS bf16_t* proj, GAS bf16_t* kst, GAS float* decb, GAS bf16_t* pbuf, const GAS float* w_up, const GAS float* b_gk, const int tid) {
    constexpr int QST = 136, JST = 72;
    const int lane = tid & 63, wave = tid >> 6, l15 = lane & 15, g4 = lane >> 4;
    LAS bf16_t* QD = (LAS bf16_t*)lds;
    LAS bf16_t* KI = QD + 64 * QST;
    LAS float* SEG = (LAS float*)(KI + 64 * QST);
    LAS float* GKS = SEG + 512;
    const int kch = tid & 127, jq = tid >> 7, mi = wave & 3, half = wave >> 2;
    for (int item = blockIdx.x; item < 2048; item += gridDim.x) {
        const int c = item & 63, h = (item >> 6) & 3, b = item >> 8;
        const size_t t0 = (size_t)b * SEQL + (size_t)c * 64;
        float wup[16];
#pragma unroll
        for (int r = 0; r < 16; ++r) wup[r] = w_up[r * 512 + h * 128 + kch];
        const float bg = b_gk[h * 128 + kch];
        u32x4 graw = (u32x4){0u, 0u, 0u, 0u};
        if (tid < 128) graw = *(const GAS u32x4*)(proj + (t0 + (tid >> 1)) * 3328 + 3072 + (tid & 1) * 8);
        unsigned short qr[16], kr[16];
#pragma unroll
        for (int jj = 0; jj < 16; ++jj) { const GAS bf16_t* rp = proj + (t0 + jq * 16 + jj) * 3328 + h * 128 + kch; qr[jj] = rp[0]; kr[jj] = rp[512]; }
        __syncthreads();
        if (tid < 128) { const int j = tid >> 1, hf = tid & 1; LAS float* gd = GKS + j * 16 + hf * 8;
            gd[0] = bflo(graw.x); gd[1] = bfhi(graw.x); gd[2] = bflo(graw.y); gd[3] = bfhi(graw.y); gd[4] = bflo(graw.z); gd[5] = bfhi(graw.z); gd[6] = bflo(graw.w); gd[7] = bfhi(graw.w); }
        asm volatile("s_waitcnt vmcnt(0)" ::: "memory");
        __syncthreads();
        float la[16]; float run = 0.f;
#pragma unroll
        for (int jj = 0; jj < 16; ++jj) { const LAS float* gr = GKS + (jq * 16 + jj) * 16; float z = bg;
#pragma unroll
            for (int r = 0; r < 16; ++r) z += gr[r] * wup[r];
            const float ls = fminf(z, 0.f) - __logf(1.0f + __expf(-fabsf(z)));
            run += ls * (1.0f / 16.0f); la[jj] = run; }
        SEG[jq * 128 + kch] = run;
        __syncthreads();
        const float s0 = SEG[kch], s1 = SEG[128 + kch], s2 = SEG[256 + kch], s3 = SEG[384 + kch];
        const float pre = (jq > 0 ? s0 : 0.f) + (jq > 1 ? s1 : 0.f) + (jq > 2 ? s2 : 0.f), tot = (s0 + s1) + (s2 + s3);
        unsigned ksp[8];
#pragma unroll
        for (int jj = 0; jj < 16; jj += 2) {
            float ksv[2];
#pragma unroll
            for (int e = 0; e < 2; ++e) { const int j = jq * 16 + jj + e; const float bb = la[jj + e] + pre; const float qf = bf2f(qr[jj + e]), kf = bf2f(kr[jj + e]);
                const bf16_t qd = f2bf(qf * 0.08838834764831845f * __expf(bb)), ki = f2bf(kf * __expf(-bb)); ksv[e] = kf * __expf(tot - bb);
                proj[(t0 + j) * 3328 + h * 128 + kch] = qd; QD[j * QST + kch] = qd; KI[j * QST + kch] = ki; }
            ksp[jj >> 1] = cvt_pk_bf16(ksv[0], ksv[1]); }
        { GAS u32x4* kd = (GAS u32x4*)(kst + (size_t)item * 8192 + kch * 64 + jq * 16); kd[0] = (u32x4){ksp[0], ksp[1], ksp[2], ksp[3]}; kd[1] = (u32x4){ksp[4], ksp[5], ksp[6], ksp[7]}; }
        if (jq == 0) decb[(size_t)item * 128 + kch] = __expf(tot);
        __syncthreads();
        f32x4 at[2] = {(f32x4){0.f, 0.f, 0.f, 0.f}, (f32x4){0.f, 0.f, 0.f, 0.f}};
#pragma unroll
        for (int ks = 0; ks < 4; ++ks) {
            const bf16x8 af = *(const LAS bf16x8*)(QD + (mi * 16 + l15) * QST + ks * 32 + 8 * g4);
#pragma unroll
            for (int t = 0; t < 2; ++t) { const bf16x8 bfr = *(const LAS bf16x8*)(KI + ((half * 2 + t) * 16 + l15) * QST + ks * 32 + 8 * g4); at[t] = mfma16(af, bfr, at[t]); }
        }
#pragma unroll
        for (int t = 0; t < 2; ++t)
#pragma unroll
            for (int r = 0; r < 4; ++r) { const int i = mi * 16 + g4 * 4 + r, j = (half * 2 + t) * 16 + l15; pbuf[(size_t)item * 4096 + i * 64 + j] = f2bf(j <= i ? at[t][r] : 0.f); }
    }
}
__device__ __forceinline__ void gla_core(LAS unsigned char* lds, const GAS bf16_t* proj, const GAS bf16_t* kst, const GAS float* decb, const GAS bf16_t* pbuf, GAS bf16_t* ost, const int tid) {
    const int lane = tid & 63, wave = tid >> 6, l15 = lane & 15, g4 = lane >> 4;
    constexpr int QST = 136, JST = 72;
    constexpr int OFF_PS = 64 * QST, OFF_KST = OFF_PS + 64 * JST, OFF_VT = OFF_KST + 128 * JST, OFF_DEC = OFF_VT + 32 * JST, BUF_EL = OFF_DEC + 256;
    LAS bf16_t* BUF = (LAS bf16_t*)lds;
    LAS bf16_t* STT = BUF + 2 * BUF_EL;
    const int mi = wave & 3, half = wave >> 2;
    for (int item = blockIdx.x; item < 256; item += gridDim.x) {
        const int vs = item & 7, h = (item >> 3) & 3, b = item >> 5;
        f32x4 st[2] = {(f32x4){0.f, 0.f, 0.f, 0.f}, (f32x4){0.f, 0.f, 0.f, 0.f}};
        __syncthreads();
        for (int i = tid; i < 32 * QST / 2; i += 512) ((LAS unsigned*)STT)[i] = 0u;
        u32x4 rq[2], rs[2], rp, rv = (u32x4){0u, 0u, 0u, 0u}; float rd = 0.f;
#define GLA_LOAD(cn) do { const size_t tn = (size_t)b * SEQL + (size_t)(cn) * 64; const size_t ci = (size_t)((b * 4 + h) * 64 + (cn)); \
            _Pragma("unroll") for (int q = 0; q < 2; ++q) { const int id = tid + 512 * q; \
                rq[q] = *(const GAS u32x4*)(proj + (tn + (id >> 4)) * 3328 + h * 128 + (id & 15) * 8); rs[q] = *(const GAS u32x4*)(kst + ci * 8192 + (size_t)id * 8); } \
            rp = *(const GAS u32x4*)(pbuf + ci * 4096 + (size_t)tid * 8); \
            if (tid < 256) rv = *(const GAS u32x4*)(proj + (tn + (tid >> 2)) * 3328 + 1024 + h * 256 + vs * 32 + (tid & 3) * 8); \
            if (tid < 128) rd = decb[ci * 128 + tid]; } while (0)
        GLA_LOAD(0);
        for (int c = 0; c < 64; ++c) {
            LAS bf16_t* QD = BUF + (c & 1) * BUF_EL; LAS bf16_t* PS = QD + OFF_PS; LAS bf16_t* KST = QD + OFF_KST; LAS bf16_t* VT = QD + OFF_VT; LAS float* DEC = (LAS float*)(QD + OFF_DEC);
            const LAS bf16_t* STR = STT + (c & 1) * 32 * QST; LAS bf16_t* STW = STT + ((c + 1) & 1) * 32 * QST;
#pragma unroll
            for (int q = 0; q < 2; ++q) { const int id = tid + 512 * q;
                *(LAS u32x4*)(QD + (id >> 4) * QST + (id & 15) * 8) = rq[q]; *(LAS u32x4*)(KST + (id >> 3) * JST + (id & 7) * 8) = rs[q]; }
            *(LAS u32x4*)(PS + (tid >> 3) * JST + (tid & 7) * 8) = rp;
            if (tid < 256) { const int j = tid >> 2, ch = tid & 3; LAS bf16_t* vd = VT + (ch * 8) * JST + j;
                vd[0 * JST] = (bf16_t)(rv.x & 0xffffu); vd[1 * JST] = (bf16_t)(rv.x >> 16); vd[2 * JST] = (bf16_t)(rv.y & 0xffffu); vd[3 * JST] = (bf16_t)(rv.y >> 16);
                vd[4 * JST] = (bf16_t)(rv.z & 0xffffu); vd[5 * JST] = (bf16_t)(rv.z >> 16); vd[6 * JST] = (bf16_t)(rv.w & 0xffffu); vd[7 * JST] = (bf16_t)(rv.w >> 16); }
            if (tid < 128) DEC[tid] = rd;
            if (c + 1 < 64) GLA_LOAD(c + 1);
            __syncthreads();
            f32x4 oacc = (f32x4){0.f, 0.f, 0.f, 0.f};
#pragma unroll
            for (int ks = 0; ks < 4; ++ks) { const bf16x8 af = *(const LAS bf16x8*)(QD + (mi * 16 + l15) * QST + ks * 32 + 8 * g4);
                const bf16x8 sfr = *(const LAS bf16x8*)(STR + (half * 16 + l15) * QST + ks * 32 + 8 * g4); oacc = mfma16(af, sfr, oacc); }
#pragma unroll
            for (int ks = 0; ks < 2; ++ks) { const bf16x8 af = *(const LAS bf16x8*)(PS + (mi * 16 + l15) * JST + ks * 32 + 8 * g4);
                const bf16x8 bfr = *(const LAS bf16x8*)(VT + (half * 16 + l15) * JST + ks * 32 + 8 * g4); oacc = mfma16(af, bfr, oacc); }
#pragma unroll
            for (int r = 0; r < 4; ++r) { const int i = mi * 16 + g4 * 4 + r;
                ost[(size_t)item * 131072 + (size_t)(c * 64 + i) * 32 + half * 16 + l15] = f2bf(oacc[r]); }
            { const float dc = DEC[wave * 16 + l15];
#pragma unroll
              for (int vt = 0; vt < 2; ++vt) { st[vt] = st[vt] * dc;
#pragma unroll
                for (int ks = 0; ks < 2; ++ks) { const bf16x8 af = *(const LAS bf16x8*)(VT + (vt * 16 + l15) * JST + ks * 32 + 8 * g4);
                    const bf16x8 bfr = *(const LAS bf16x8*)(KST + (wave * 16 + l15) * JST + ks * 32 + 8 * g4); st[vt] = mfma16(af, bfr, st[vt]); }
#pragma unroll
                for (int r = 0; r < 4; ++r) STW[(vt * 16 + g4 * 4 + r) * QST + wave * 16 + l15] = f2bf(st[vt][r]); } }
        }
#undef GLA_LOAD
    }
}
__device__ __forceinline__ void gla_post(GAS bf16_t* proj, const GAS bf16_t* ost, const GAS float* o_norm, const int tid) {
    const int lane = tid & 63, wave = tid >> 6;
    const int gw = blockIdx.x * 8 + wave, NGW = gridDim.x * 8;
    float gn[16];
#pragma unroll
    for (int e = 0; e < 16; ++e) gn[e] = o_norm[(lane & 15) * 16 + e];
    for (int r = gw; r < MROWS; r += NGW) {
        const int b = r >> 12, t = r & 4095, h = lane >> 4, p = lane & 15;
        const GAS u32x4* op = (const GAS u32x4*)(ost + (size_t)((b * 4 + h) * 8 + (p >> 1)) * 131072 + (size_t)t * 32 + (p & 1) * 16);
        GAS u32x4* dp = (GAS u32x4*)(proj + (size_t)r * 3328 + 1024 + lane * 16); const GAS u32x4* rp = (const GAS u32x4*)(proj + (size_t)r * 3328 + 2048 + lane * 16);
        const u32x4 ov0 = op[0], ov1 = op[1];
        float hs = 0.f;
#pragma unroll
        for (int e = 0; e < 4; ++e) { const float a0 = bflo(ov0[e]), a1 = bfhi(ov0[e]), c0 = bflo(ov1[e]), c1 = bfhi(ov1[e]); hs += (a0 * a0 + a1 * a1) + (c0 * c0 + c1 * c1); }
        hs += __shfl_xor(hs, 1); hs += __shfl_xor(hs, 2); hs += __shfl_xor(hs, 4); hs += __shfl_xor(hs, 8);
        const float rs = __builtin_amdgcn_rsqf(hs * (1.0f / 256.0f) + pg8::RMS_EPS);
#pragma unroll
        for (int q = 0; q < 2; ++q) { const u32x4 ov = q ? ov1 : ov0, rv = rp[q]; u32x4 w;
#pragma unroll
            for (int e = 0; e < 4; ++e) { const float o0 = bflo(ov[e]), o1 = bfhi(ov[e]), r0 = bflo(rv[e]), r1 = bfhi(rv[e]);
                w[e] = cvt_pk_bf16(o0 * rs * gn[q * 8 + 2 * e] * pg8::silu_f(r0), o1 * rs * gn[q * 8 + 2 * e + 1] * pg8::silu_f(r1)); }
            dp[q] = w; }
    }
}

__device__ __forceinline__ void sgu_spatial(LAS unsigned char* lds, GAS bf16_t* uv  , const GAS float* lnstat  , int row0,
                                            const GAS float* ln_g, const GAS float* ln_b, const GAS float* w_s, const GAS float* b_s, const int tid) {
    const int lane = tid & 63, wave = tid >> 6, l15 = lane & 15, g4 = lane >> 4;
    constexpr int ST = 136;
    LAS bf16_t* WS = (LAS bf16_t*)lds;
    LAS bf16_t* VT = WS + 128 * ST;
    LAS float* STAT = (LAS float*)(VT + 384 * ST);
    int gcur = -1;
    for (int item = blockIdx.x; item < 1024; item += gridDim.x) {
        const int cc = item >> 3, g = item & 7;
        __syncthreads();
        if (g != gcur) { gcur = g;
            for (int idx = tid; idx < 128 * 32; idx += 512) { const int i = idx >> 5, j4 = (idx & 31) * 4;
                const f32x4 w = *(const GAS f32x4*)(w_s + (size_t)g * 16384 + i * 128 + j4);
                u32x2 o; o.x = cvt_pk_bf16(j4 <= i ? w[0] : 0.f, j4 + 1 <= i ? w[1] : 0.f); o.y = cvt_pk_bf16(j4 + 2 <= i ? w[2] : 0.f, j4 + 3 <= i ? w[3] : 0.f);
                *(LAS u32x2*)(WS + i * ST + j4) = o; } }
        if (tid < 128) { const GAS f32x4* lp = (const GAS f32x4*)(lnstat + 24 * (size_t)(row0 + cc * 128 + tid)); float s1 = 0.f, s2 = 0.f;
#pragma unroll
            for (int q = 0; q < 6; ++q) { const f32x4 v = lp[q]; s1 += v[0] + v[2]; s2 += v[1] + v[3]; }
            const float mean = s1 * (1.0f / 3072.0f), var = s2 * (1.0f / 3072.0f) - mean * mean;
            STAT[2 * tid] = mean; STAT[2 * tid + 1] = __builtin_amdgcn_rsqf(fmaxf(var, 0.f) + pg8::RMS_EPS); }
        __syncthreads();
        for (int idx = tid; idx < 32 * 48; idx += 512) { const int jg = idx / 48, ch = idx % 48, j0 = jg * 4;
            const f32x4 ga = *(const GAS f32x4*)(ln_g + g * 384 + ch * 8), gb = *(const GAS f32x4*)(ln_g + g * 384 + ch * 8 + 4);
            const f32x4 ba = *(const GAS f32x4*)(ln_b + g * 384 + ch * 8), bb = *(const GAS f32x4*)(ln_b + g * 384 + ch * 8 + 4);
            float vn[4][8];
#pragma unroll
            for (int q = 0; q < 4; ++q) { const int tl = cc * 128 + j0 + q;
                const u32x4 raw = *(const GAS u32x4*)(uv + (size_t)tl * 6144 + 3072 + g * 384 + ch * 8);
                const float mean = STAT[2 * (j0 + q)], rs = STAT[2 * (j0 + q) + 1];
                vn[q][0] = (bflo(raw.x) - mean) * rs * ga[0] + ba[0]; vn[q][1] = (bfhi(raw.x) - mean) * rs * ga[1] + ba[1];
                vn[q][2] = (bflo(raw.y) - mean) * rs * ga[2] + ba[2]; vn[q][3] = (bfhi(raw.y) - mean) * rs * ga[3] + ba[3];
                vn[q][4] = (bflo(raw.z) - mean) * rs * gb[0] + bb[0]; vn[q][5] = (bfhi(raw.z) - mean) * rs * gb[1] + bb[1];
                vn[q][6] = (bflo(raw.w) - mean) * rs * gb[2] + bb[2]; vn[q][7] = (bfhi(raw.w) - mean) * rs * gb[3] + bb[3]; }
#pragma unroll
            for (int e = 0; e < 8; ++e) { u32x2 o; o.x = cvt_pk_bf16(vn[0][e], vn[1][e]); o.y = cvt_pk_bf16(vn[2][e], vn[3][e]); *(LAS u32x2*)(VT + (ch * 8 + e) * ST + (((j0 >> 2) ^ ((ch & 7) << 1)) << 2)) = o; } }
        __syncthreads();
        f32x4 acc[8][3];
#pragma unroll
        for (int mt = 0; mt < 8; ++mt)
#pragma unroll
            for (int nt = 0; nt < 3; ++nt) acc[mt][nt] = (f32x4){0.f, 0.f, 0.f, 0.f};
#pragma unroll
        for (int ks = 0; ks < 4; ++ks) {
            bf16x8 bfr[3];
#pragma unroll
            for (int nt = 0; nt < 3; ++nt) { const int row = wave * 48 + nt * 16 + l15; bfr[nt] = *(const LAS bf16x8*)(VT + row * ST + (((ks * 4 + g4) ^ ((row >> 3) & 7)) << 3)); }
#pragma unroll
            for (int mt = 0; mt < 8; ++mt) { if (ks * 32 <= mt * 16 + 15) {
                const bf16x8 af = *(const LAS bf16x8*)(WS + (mt * 16 + l15) * ST + ks * 32 + 8 * g4);
#pragma unroll
                for (int nt = 0; nt < 3; ++nt) acc[mt][nt] = mfma16(bfr[nt], af, acc[mt][nt]); } }
        }
        u32x2 uuv[8][3]; float bsv[8];
#pragma unroll
        for (int mt = 0; mt < 8; ++mt) { const int i = mt * 16 + l15; bsv[mt] = b_s[g * 128 + i];
            const GAS bf16_t* up = uv + (size_t)(cc * 128 + i) * 6144 + g * 384 + wave * 48 + g4 * 4;
#pragma unroll
            for (int nt = 0; nt < 3; ++nt) uuv[mt][nt] = *(const GAS u32x2*)(up + nt * 16); }
#pragma unroll
        for (int mt = 0; mt < 8; ++mt) { const int i = mt * 16 + l15; const float bs = bsv[mt];
            GAS bf16_t* up = uv + (size_t)(cc * 128 + i) * 6144 + g * 384 + wave * 48 + g4 * 4;
#pragma unroll
            for (int nt = 0; nt < 3; ++nt) { const u32x2 uu = uuv[mt][nt]; u32x2 o;
                o.x = cvt_pk_bf16(bflo(uu.x) * (acc[mt][nt][0] + bs), bfhi(uu.x) * (acc[mt][nt][1] + bs)); o.y = cvt_pk_bf16(bflo(uu.y) * (acc[mt][nt][2] + bs), bfhi(uu.y) * (acc[mt][nt][3] + bs));
                *(GAS u32x2*)(up + nt * 16) = o; } }
    }
}

__device__ __forceinline__ u32x4 rope8(const GAS bf16_t* p16  , const GAS float* cs  , bool second) {
    const u32x4 x1 = *(const GAS u32x4*)p16, x2 = *(const GAS u32x4*)(p16 + 8);
    const f32x4 c0 = *(const GAS f32x4*)cs, c1 = *(const GAS f32x4*)(cs + 4), s0 = *(const GAS f32x4*)(cs + 8), s1 = *(const GAS f32x4*)(cs + 12);
    float o[8];
#pragma unroll
    for (int e = 0; e < 4; ++e) {
        const float a0 = bflo(x1[e]), a1 = bfhi(x1[e]), b0 = bflo(x2[e]), b1 = bfhi(x2[e]);
        const float cc0 = (e < 2) ? c0[2 * e] : c1[2 * e - 4], cc1 = (e < 2) ? c0[2 * e + 1] : c1[2 * e - 3];
        const float ss0 = (e < 2) ? s0[2 * e] : s1[2 * e - 4], ss1 = (e < 2) ? s0[2 * e + 1] : s1[2 * e - 3];
        o[2 * e] = second ? (b0 * cc0 + a0 * ss0) : (a0 * cc0 - b0 * ss0);
        o[2 * e + 1] = second ? (b1 * cc1 + a1 * ss1) : (a1 * cc1 - b1 * ss1);
    }
    u32x4 w; w.x = cvt_pk_bf16(o[0], o[1]); w.y = cvt_pk_bf16(o[2], o[3]); w.z = cvt_pk_bf16(o[4], o[5]); w.w = cvt_pk_bf16(o[6], o[7]); return w;
}
__device__ __forceinline__ void swa_attn(LAS unsigned char* lds, const GAS bf16_t* qkv  , GAS bf16_t* ao  , const GAS float* rope, const GAS float* sinks, const int tid) {
    const int lane = tid & 63, wave = tid >> 6, l15 = lane & 15, g4 = lane >> 4;
    constexpr int KSTR = 72, VSTR = 264, PSTR = 168;
    LAS bf16_t* Ks = (LAS bf16_t*)lds;
    LAS bf16_t* Vt = Ks + 256 * KSTR;
    LAS bf16_t* Ps = Vt + 64 * VSTR + wave * 16 * PSTR;
    for (int item = blockIdx.x; item < 512; item += gridDim.x) {
        const int kvh = item & 1, n = (item >> 1) & 31, b = item >> 6;
        const int tok0 = b * SEQL + n * 128;
        __syncthreads();
        for (int idx = tid; idx < 256 * 8; idx += 512) {
            const int jb = idx >> 3, ch = idx & 7; const int tok = tok0 - 128 + jb;
            u32x4 kq = (u32x4){0u, 0u, 0u, 0u}, vq = (u32x4){0u, 0u, 0u, 0u};
            if (n > 0 || jb >= 128) {
                const GAS bf16_t* krow = qkv + (size_t)tok * 1280 + 1024 + kvh * 64;
                vq = *(const GAS u32x4*)(qkv + (size_t)tok * 1280 + 1152 + kvh * 64 + ch * 8);
                if (ch < 2) kq = rope8(krow, rope + (size_t)tok * 16, ch == 1); else kq = *(const GAS u32x4*)(krow + ch * 8);
            }
            *(LAS u32x4*)(Ks + jb * KSTR + ch * 8) = kq;
            LAS bf16_t* vd = Vt + (ch * 8) * VSTR + jb;
            vd[0 * VSTR] = (bf16_t)(vq.x & 0xffffu); vd[1 * VSTR] = (bf16_t)(vq.x >> 16); vd[2 * VSTR] = (bf16_t)(vq.y & 0xffffu); vd[3 * VSTR] = (bf16_t)(vq.y >> 16);
            vd[4 * VSTR] = (bf16_t)(vq.z & 0xffffu); vd[5 * VSTR] = (bf16_t)(vq.z >> 16); vd[6 * VSTR] = (bf16_t)(vq.w & 0xffffu); vd[7 * VSTR] = (bf16_t)(vq.w >> 16);
        }
        __syncthreads();
        const int hq = kvh * 8 + wave; const float sink = sinks[hq];
        for (int i = 0; i < 8; ++i) {
            const int qtok = tok0 + 16 * i + l15; const GAS bf16_t* qp = qkv + (size_t)qtok * 1280 + hq * 64;
            bf16x8 qa[2];
            qa[1] = *(const GAS bf16x8*)(qp + 32 + 8 * g4);
            { u32x4 q0; if (g4 < 2) q0 = rope8(qp, rope + (size_t)qtok * 16, g4 == 1); else q0 = *(const GAS u32x4*)(qp + 8 * g4); qa[0] = __builtin_bit_cast(bf16x8, q0); }
            const int t0 = (i < 6) ? i : 6;
            f32x4 s[10];
#pragma unroll
            for (int nt = 0; nt < 10; ++nt) { s[nt] = (f32x4){0.f, 0.f, 0.f, 0.f};
#pragma unroll
                for (int ks = 0; ks < 2; ++ks) { const bf16x8 kb = *(const LAS bf16x8*)(Ks + ((t0 + nt) * 16 + l15) * KSTR + ks * 32 + 8 * g4); s[nt] = mfma16(qa[ks], kb, s[nt]); } }
            float inv[4];
#pragma unroll
            for (int r = 0; r < 4; ++r) {
                const int ql = 16 * i + g4 * 4 + r; float mx = sink;
#pragma unroll
                for (int nt = 0; nt < 10; ++nt) { const int jb = (t0 + nt) * 16 + l15; const bool ok = (jb > ql) && (jb <= ql + 128) && (n > 0 || jb >= 128);
                    const float v = ok ? s[nt][r] * 0.125f : -INFINITY; s[nt][r] = v; mx = fmaxf(mx, v); }
                mx = fmaxf(mx, __shfl_xor(mx, 1)); mx = fmaxf(mx, __shfl_xor(mx, 2)); mx = fmaxf(mx, __shfl_xor(mx, 4)); mx = fmaxf(mx, __shfl_xor(mx, 8));
                float sum = 0.f;
#pragma unroll
                for (int nt = 0; nt < 10; ++nt) { const float p = __expf(s[nt][r] - mx); sum += p; Ps[(g4 * 4 + r) * PSTR + nt * 16 + l15] = f2bf(p); }
                sum += __shfl_xor(sum, 1); sum += __shfl_xor(sum, 2); sum += __shfl_xor(sum, 4); sum += __shfl_xor(sum, 8);
                inv[r] = 1.0f / (sum + __expf(sink - mx));
            }
            asm volatile("s_waitcnt lgkmcnt(0)" ::: "memory");
            f32x4 o[4] = {(f32x4){0.f, 0.f, 0.f, 0.f}, (f32x4){0.f, 0.f, 0.f, 0.f}, (f32x4){0.f, 0.f, 0.f, 0.f}, (f32x4){0.f, 0.f, 0.f, 0.f}};
#pragma unroll
            for (int ks = 0; ks < 5; ++ks) { const bf16x8 pa = *(const LAS bf16x8*)(Ps + l15 * PSTR + ks * 32 + 8 * g4);
#pragma unroll
                for (int dt = 0; dt < 4; ++dt) { const bf16x8 vb = *(const LAS bf16x8*)(Vt + (dt * 16 + l15) * VSTR + t0 * 16 + ks * 32 + 8 * g4); o[dt] = mfma16(pa, vb, o[dt]); } }
            asm volatile("s_waitcnt lgkmcnt(0)" ::: "memory");
#pragma unroll
            for (int r = 0; r < 4; ++r) { GAS bf16_t* op = ao + (size_t)(tok0 + 16 * i + g4 * 4 + r) * 1024 + hq * 64 + l15;
#pragma unroll
                for (int dt = 0; dt < 4; ++dt) op[dt * 16] = f2bf(o[dt][r] * inv[r]); }
        }
    }
}

__device__ __forceinline__ void final_norm(const GAS bf16_t* xb, GAS float* out, const GAS float* ssq, const GAS float* gain, const int tid) {
    const int lane = tid & 63, wave = tid >> 6, gw = blockIdx.x * 8 + wave, NGW = gridDim.x * 8;
    f32x4 gv[4];
#pragma unroll
    for (int j = 0; j < 4; ++j) gv[j] = *((const GAS f32x4*)(gain + lane * 16) + j);
    for (int r = gw; r < MROWS; r += NGW) { const float rs = __builtin_amdgcn_rsqf(pg8::ssq4(ssq, r) * (1.0f / 1024.0f) + pg8::RMS_EPS);
        const GAS u32x4* xp = (const GAS u32x4*)(xb + (size_t)r * 1024 + lane * 16); GAS f32x4* op = (GAS f32x4*)(out + (size_t)r * 1024 + lane * 16);
        const u32x4 a = xp[0], b = xp[1];
        op[0] = (f32x4){bflo(a.x), bfhi(a.x), bflo(a.y), bfhi(a.y)} * rs * gv[0]; op[1] = (f32x4){bflo(a.z), bfhi(a.z), bflo(a.w), bfhi(a.w)} * rs * gv[1];
        op[2] = (f32x4){bflo(b.x), bfhi(b.x), bflo(b.y), bfhi(b.y)} * rs * gv[2]; op[3] = (f32x4){bflo(b.z), bfhi(b.z), bflo(b.w), bfhi(b.w)} * rs * gv[3]; }
}

#define XB_TMO      128
#define XB_XCNT(j)  (256  + 64 * (j))
#define XB_XSUB(j)  (1280 + 64 * (j))
#define XB_XGEN(j)  (2304 + 64 * (j))
#define XB_TOP      3328
#define XB_TOPGEN   3392
#define XCD_BAR_WORDS 3456
#define XB_SPIN_CAP (1u << 18)

__device__ __forceinline__ unsigned xb_ld(unsigned* p)              { return __hip_atomic_load(p, __ATOMIC_RELAXED, __HIP_MEMORY_SCOPE_AGENT); }
__device__ __forceinline__ unsigned xb_add(unsigned* p, unsigned v) { return __hip_atomic_fetch_add(p, v, __ATOMIC_RELAXED, __HIP_MEMORY_SCOPE_AGENT); }
__device__ __forceinline__ unsigned xb_xcc_id() { return (unsigned)__builtin_amdgcn_s_getreg((3 << 11) | 20) & 0xFu; }
#define XB_SPIN(cond, bar) do { unsigned _sp = 0; while (cond) { __builtin_amdgcn_s_sleep(1); \
    if ((++_sp & 255u) == 0u) { if (xb_ld(&(bar)[XB_TMO])) break; if (_sp > XB_SPIN_CAP) { atomicAdd(&(bar)[XB_TMO], 1u); break; } } } } while (0)

struct XcdBarrier {
    unsigned* bar; unsigned x;
    volatile LAS unsigned* st;
};

__device__ __forceinline__ XcdBarrier xcd_barrier_post(unsigned* bar, volatile LAS unsigned* st) {
    XcdBarrier b; b.bar = bar; b.x = xb_xcc_id(); b.st = st;
    if (threadIdx.x == 0) (void)xb_add(&bar[XB_XCNT(b.x)], 1u);
    return b;
}
__device__ __forceinline__ void xcd_barrier_complete(unsigned* bar, unsigned x, unsigned& nloc, unsigned& nx) {
    const unsigned G = gridDim.x * gridDim.y * gridDim.z;
    unsigned sum, cnt, mine, sp = 0u;
    for (;;) {
        sum = 0u; cnt = 0u; mine = 0u;
#pragma unroll
        for (unsigned j = 0; j < 16; ++j) { const unsigned c = xb_ld(&bar[XB_XCNT(j)]); sum += c; cnt += (c > 0u) ? 1u : 0u; mine = (j == x) ? c : mine; }
        if (sum == G) break;
        __builtin_amdgcn_s_sleep(1);
        if ((++sp & 255u) == 0u) { if (xb_ld(&bar[XB_TMO])) break; if (sp > XB_SPIN_CAP) { atomicAdd(&bar[XB_TMO], 1u); break; } }
    }
    nloc = mine > 0u ? mine : 1u; nx = cnt > 0u ? cnt : 1u;
}

__device__ __forceinline__ void xcd_barrier(const XcdBarrier& b) {
    asm volatile("s_waitcnt vmcnt(0)" ::: "memory");
    __syncthreads();
    if (threadIdx.x == 0) {
        unsigned* bar = b.bar;
        __builtin_amdgcn_s_waitcnt(0);
        unsigned nloc = b.st[0], nx = b.st[1];
        if (nloc == 0u) { xcd_barrier_complete(bar, b.x, nloc, nx); b.st[0] = nloc; b.st[1] = nx; }
        const unsigned old = xb_add(&bar[XB_XSUB(b.x)], 1u);
        const unsigned gen = old / nloc;
        if (old + 1u == (gen + 1u) * nloc) {
            __builtin_amdgcn_fence(__ATOMIC_RELEASE, "agent");
            asm volatile("s_waitcnt vmcnt(0)" ::: "memory");
            const unsigned og = xb_add(&bar[XB_TOP], 1u);
            const unsigned tg = og / nx;
            if (og + 1u == (tg + 1u) * nx) xb_add(&bar[XB_TOPGEN], 1u);
            else XB_SPIN(xb_ld(&bar[XB_TOPGEN]) == tg, bar);
            __builtin_amdgcn_fence(__ATOMIC_ACQUIRE, "agent");
            xb_add(&bar[XB_XGEN(b.x)], 1u);
            asm volatile("s_waitcnt vmcnt(0)" ::: "memory");
        } else {
            XB_SPIN(xb_ld(&bar[XB_XGEN(b.x)]) == gen, bar);
            __builtin_amdgcn_fence(__ATOMIC_ACQUIRE, "agent");
            asm volatile("s_waitcnt vmcnt(0)" ::: "memory");
        }
    }
    __syncthreads();
}

#define OPW(k, l, s, h) ((unsigned short)((k) | ((l) << 4) | ((s) << 8) | ((h) << 9)))
constexpr int NOPS = 37;
__constant__ unsigned short OPS[NOPS] = {
    OPW(0,0,0,0),
    OPW(1,0,0,0), OPW(2,0,0,0), OPW(3,0,0,0), OPW(12,0,0,0), OPW(5,0,0,0), OPW(6,0,0,0), OPW(4,0,0,0), OPW(1,0,1,0), OPW(2,0,1,0),
    OPW(1,1,0,0), OPW(2,1,0,0), OPW(3,1,0,0), OPW(7,1,0,0), OPW(4,1,0,0), OPW(3,1,0,1), OPW(7,1,0,1), OPW(4,1,0,1), OPW(1,1,1,0), OPW(2,1,1,0),
    OPW(1,2,0,0), OPW(2,2,0,0), OPW(3,2,0,0), OPW(8,2,0,0), OPW(4,2,0,0), OPW(1,2,1,0), OPW(2,2,1,0),
    OPW(1,3,0,0), OPW(2,3,0,0), OPW(3,3,0,0), OPW(12,3,0,0), OPW(5,3,0,0), OPW(6,3,0,0), OPW(4,3,0,0), OPW(1,3,1,0), OPW(2,3,1,0),
    OPW(9,0,0,0) };

__global__ void __launch_bounds__(512, 2) mega_fwd(Args a) {
    extern __shared__ __attribute__((aligned(16))) unsigned char lds_raw[];
    LAS unsigned char* lds = (LAS unsigned char*)lds_raw;
    cg::grid_group grid = cg::this_grid();
    const int G = gridDim.x;
    volatile LAS unsigned* barst = (volatile LAS unsigned*)(lds + LDS_BYTES - 16);
    if (threadIdx.x < 4) barst[threadIdx.x] = 0u;
    __syncthreads();
    (void)xcd_barrier_post((unsigned*)(a.ws + WS_BAR), barst);
    for (int op = 0; op < NOPS; ++op) {
        int tid; asm volatile("v_mov_b32 %0, %1" : "=v"(tid) : "v"((int)threadIdx.x));
        KPTR kp = (KPTR)__builtin_amdgcn_kernarg_segment_ptr(); asm volatile("" : "+s"(kp));
        GAS unsigned char* ws = (GAS unsigned char*)kp[53]; GAS float* outp = (GAS float*)kp[52];
        GAS bf16_t* xb = (GAS bf16_t*)(ws + WS_XB); GAS bf16_t* temp = (GAS bf16_t*)(ws + WS_TEMP);
        GAS float* ssq = (GAS float*)(ws + WS_SSQ); GAS float* lnstat = (GAS float*)(ws + WS_LNSTAT);
        const unsigned w = OPS[op]; const int kind = w & 15, L = (w >> 4) & 3, sub = (w >> 8) & 1, hf = (w >> 9) & 1;
        const int base = layer_base(L);
        if (kind == 0) { p0_prologue(kp, ws, lds, tid); }
        else if (kind == 1) {
            pg8::Gemm g{xb, (const GAS bf16_t*)(ws + WS_FFN + (size_t)(L * 2 + sub) * SZ_FFN), MROWS, 5632, 1024, 1024};
            pg8::StaticOrder S; S.init(MROWS, 5632, G, (int)blockIdx.x);
            pg8::EpiSwiGLU E{temp, DFF, ssq + (size_t)(3 * L + 2 * sub) * 4 * MROWS, (LAS f32x4*)(lds + 139264 + tid * 32)};
            pg8::gemm_phase<pg8::EpiSwiGLU, pg8::StaticOrder, true, true>(lds, g, S, E, tid);
        } else if (kind == 2) {
            pg8::Gemm g{temp, (const GAS bf16_t*)(ws + WS_FFN + (size_t)(L * 2 + sub) * SZ_FFN + SZ_FFN_IN), MROWS, 1024, 2816, 2816};
            pg8::StaticOrder S; S.init(MROWS, 1024, G, (int)blockIdx.x);
            pg8::EpiRes E{xb, ssq + (size_t)(3 * L + 2 * sub + 1) * 4 * MROWS, nullptr, 0.5f, 0, (LAS float*)(lds + 131072), tid};
            pg8::gemm_phase<pg8::EpiRes, pg8::StaticOrder, true, true>(lds, g, S, E, tid);
        } else if (kind == 3) {
            const GAS bf16_t* Bt = (const GAS bf16_t*)mixer_w(ws, L);
            const int Mh = (L == 1) ? MROWS / 2 : MROWS, N = (L == 1) ? 6144 : (L == 2 ? 1280 : 3328), row0 = hf * (MROWS / 2);
            pg8::Gemm g{xb + (size_t)row0 * 1024, Bt, Mh, N, 1024, 1024};
            pg8::StaticOrder S; S.init(Mh, N, G, (int)blockIdx.x);
            pg8::EpiPlain E{temp, N, ssq + (size_t)(3 * L + 1) * 4 * MROWS, (L == 2) ? ARGP(32) : nullptr, (L == 1) ? 1 : 0, (L == 1) ? lnstat : nullptr, 12, row0, (LAS float*)(lds + 131072), tid, (LAS f32x4*)(lds + 139264 + tid * 32)};
            pg8::gemm_phase<pg8::EpiPlain, pg8::StaticOrder, true, true>(lds, g, S, E, tid);
        } else if (kind == 4) {
            const GAS bf16_t* Bt = (const GAS bf16_t*)(mixer_w(ws, L) + mixer_in_sz(L));
            const int Mh = (L == 1) ? MROWS / 2 : MROWS, K = (L == 1) ? 3072 : 1024, row0 = hf * (MROWS / 2);
            const GAS bf16_t* A = (L == 1) ? temp : (L == 2 ? temp + (size_t)MROWS * 1280 : temp + 1024);
            const int lda = (L == 1) ? 6144 : (L == 2 ? 1024 : 3328);
            pg8::Gemm g{A, Bt, Mh, 1024, K, lda};
            pg8::StaticOrder S; S.init(Mh, 1024, G, (int)blockIdx.x);
            pg8::EpiRes E{xb, ssq + (size_t)(3 * L + 2) * 4 * MROWS, (L == 2) ? ARGP(35) : nullptr, 1.0f, row0, (LAS float*)(lds + 131072), tid};
            pg8::gemm_phase<pg8::EpiRes, pg8::StaticOrder, true, true>(lds, g, S, E, tid);
        } else if (kind == 5) { gla_core(lds, temp, (const GAS bf16_t*)(ws + WS_KST), (const GAS float*)(ws + WS_DEC), (const GAS bf16_t*)(ws + WS_PBUF), (GAS bf16_t*)outp, tid); }
        else if (kind == 12) { gla_pre(lds, temp, (GAS bf16_t*)(ws + WS_KST), (GAS float*)(ws + WS_DEC), (GAS bf16_t*)(ws + WS_PBUF), ARGP(base + 5), ARGP(base + 6), tid); }
        else if (kind == 6) { gla_post(temp, (const GAS bf16_t*)outp, ARGP(base + 7), tid); }
        else if (kind == 7) { sgu_spatial(lds, temp, lnstat, hf * (MROWS / 2), ARGP(19), ARGP(20), ARGP(21), ARGP(22), tid); }
        else if (kind == 8) { swa_attn(lds, temp, temp + (size_t)MROWS * 1280, (const GAS float*)(ws + WS_ROPE), ARGP(33), tid); }
        else { final_norm(xb, outp, ssq + (size_t)12 * 4 * MROWS, ARGP(51), tid); }
        if (G == 0x7fffffff) {
            grid.sync();
        } else if (op + 1 < NOPS) { XcdBarrier xbar; xbar.bar = (unsigned*)((unsigned char*)kp[53] + WS_BAR); xbar.x = xb_xcc_id(); xbar.st = (volatile LAS unsigned*)(lds + LDS_BYTES - 16); xcd_barrier(xbar); }
    }
}

extern "C" void kernel_launch(void* const* d_in, const int* in_sizes, int n_in, void* d_out, int out_size, void* d_ws, size_t ws_size, hipStream_t stream) {
    static int grid = 0;
    if (grid == 0) {
        if (n_in != 52 || out_size != MROWS * DM || ws_size < WS_END2) { fprintf(stderr, "kernel_launch: unexpected shapes: n_in %d out %d ws %zu (need %zu)\n", n_in, out_size, ws_size, (size_t)WS_END2); grid = -1; return; }
        int dev = 0, cus = 0, per_cu = 0;
        hipGetDevice(&dev); hipDeviceGetAttribute(&cus, hipDeviceAttributeMultiprocessorCount, dev);
        if (hipFuncSetAttribute((const void*)mega_fwd, hipFuncAttributeMaxDynamicSharedMemorySize, LDS_BYTES) != hipSuccess) { fprintf(stderr, "kernel_launch: hipFuncSetAttribute failed\n"); grid = -1; return; }
        if (hipOccupancyMaxActiveBlocksPerMultiprocessor(&per_cu, (const void*)mega_fwd, 512, LDS_BYTES) != hipSuccess || per_cu < 1) { fprintf(stderr, "kernel_launch: occupancy query says %d\n", per_cu); per_cu = 1; }
        (void)hipGetLastError();
        grid = cus;
    }
    if (grid < 0) return;
    if (hipMemsetAsync((char*)d_ws + WS_BAR, 0, WS_BAR_BYTES, stream) != hipSuccess) { fprintf(stderr, "kernel_launch: memset of barrier words failed\n"); return; }
    Args a{};
    for (int i = 0; i < 52; ++i) a.in[i] = (const float*)d_in[i];
    a.out = (float*)d_out; a.ws = (unsigned char*)d_ws;
    void* args[] = {&a};
    hipError_t e = hipLaunchCooperativeKernel((const void*)mega_fwd, dim3(grid), dim3(512), args, LDS_BYTES, stream);
    if (e != hipSuccess) fprintf(stderr, "kernel_launch: cooperative launch failed: %s (grid %d)\n", hipGetErrorString(e), grid);
}
```
